# Optimizing an MI355X kernel written in HIP

```python
import jax, jax.numpy as jnp
from jax import lax
import numpy as np

D_MODEL = 2048
BATCH = 4
SEQ = 2048
DEPTH = 4

CHUNK = 64
LEFT_CHUNKS = 8
N_BAND = LEFT_CHUNKS + 1
HEAD_DIM = 128
D_MIX = D_MODEL
D_A = D_MIX // 2
D_B = D_MIX - D_A
H_A = D_A // HEAD_DIM
H_B = D_B // HEAD_DIM
REL_CLIP = 128
H_IDX = 8
D_IDX = 64
TOPK_MAX = 256
Q_BLOCK = 128
D_PLE = 256
ROPE_THETA = 10000.0
LN_EPS = 1e-5
NEG = -1e30
ALPHA = (2.0 * DEPTH) ** 0.25
BETA = (8.0 * DEPTH) ** -0.25
SPLIT_SIZES = (D_A, D_A, D_A, D_A, D_B, HEAD_DIM, HEAD_DIM, D_B, H_IDX * D_IDX, D_IDX, H_IDX)
V_PARTS = (2, 6)
D_IN = sum(SPLIT_SIZES)
SPLIT_IDX = tuple(int(v) for v in np.cumsum(SPLIT_SIZES)[:-1])

kernel_name = 'hybrid_chunk_relpos_dsa_deepnorm'


def layer_norm(x, g, b):
    xf = x.astype(jnp.float32)
    mu = jnp.mean(xf, -1, keepdims=True)
    var = jnp.mean(jnp.square(xf - mu), -1, keepdims=True)
    y = (xf - mu) * lax.rsqrt(var + LN_EPS)
    return (y * g.astype(jnp.float32) + b.astype(jnp.float32)).astype(x.dtype)


def rope_tables(positions, dim):
    inv = ROPE_THETA ** (-jnp.arange(0, dim, 2, dtype=jnp.float32) / dim)
    ang = positions.astype(jnp.float32)[..., None] * inv
    ang = jnp.concatenate([ang, ang], -1)[:, :, None, :]
    return jnp.cos(ang), jnp.sin(ang)


def apply_rope(t, cos, sin):
    t1, t2 = jnp.split(t, 2, axis=-1)
    rot = jnp.concatenate([-t2, t1], -1)
    return (t.astype(jnp.float32) * cos + rot.astype(jnp.float32) * sin).astype(t.dtype)


def chunk_relpos_attention(q, k, v, rel_bias):
    Bn, S, H, Dh = q.shape
    nc = S // CHUNK
    qc = q.reshape(Bn, nc, CHUNK, H, Dh)

    def band(t):
        t = t.reshape(Bn, nc, CHUNK, H, Dh)
        tp = jnp.pad(t, ((0, 0), (LEFT_CHUNKS, 0), (0, 0), (0, 0), (0, 0)))
        return jnp.concatenate([tp[:, j:j + nc] for j in range(N_BAND)], axis=2)

    kb, vb = band(k), band(v)
    s = jnp.einsum('bnqhd,bnkhd->bnhqk', qc, kb).astype(jnp.float32) * (Dh ** -0.5)
    qi = jnp.arange(CHUNK)[:, None]
    slot = jnp.arange(N_BAND * CHUNK)[None, :]
    dist = LEFT_CHUNKS * CHUNK + qi - slot
    bias = rel_bias[:, jnp.clip(dist, -REL_CLIP, REL_CLIP) + REL_CLIP]
    key_chunk = jnp.arange(nc)[:, None] - LEFT_CHUNKS + slot // CHUNK
    s = s + bias.astype(jnp.float32)[None, None]
    s = jnp.where((key_chunk >= 0)[None, :, None, None, :], s, NEG)
    pr = jax.nn.softmax(s, axis=-1).astype(v.dtype)
    o = jnp.einsum('bnhqk,bnkhd->bnqhd', pr, vb)
    return o.reshape(Bn, S, H * Dh)


def indexed_sparse_attention(q, k, v, q_idx, k_idx, w_idx, topk):
    Bn, S = q.shape[:2]
    nb = S // Q_BLOCK
    key_pos = jnp.arange(S)

    def blockify(t):
        return jnp.moveaxis(t.reshape((Bn, nb, Q_BLOCK) + t.shape[2:]), 1, 0)

    def one_block(args):
        blk, qb, qib, wib = args
        t = blk * Q_BLOCK + jnp.arange(Q_BLOCK)
        visible_end = (t // CHUNK + 1) * CHUNK
        admissible = key_pos[None, :] < visible_end[:, None]
        dots = jnp.einsum('bqhd,bsd->bqhs', qib, k_idx).astype(jnp.float32) * (D_IDX ** -0.5)
        score = jnp.einsum('bqh,bqhs->bqs', wib.astype(jnp.float32) * (H_IDX ** -0.5), jax.nn.relu(dots))
        score = jnp.where(admissible[None], score, NEG)
        top_val, top_idx = lax.top_k(score, topk)
        sel_valid = top_val > 0.5 * NEG
        k_sel = jax.vmap(lambda kk, ii: kk[ii])(k, top_idx)
        v_sel = jax.vmap(lambda vv, ii: vv[ii])(v, top_idx)
        s = jnp.einsum('bqhd,bqkd->bhqk', qb, k_sel).astype(jnp.float32) * (HEAD_DIM ** -0.5)
        s = jnp.where(sel_valid[:, None], s, NEG)
        pr = jax.nn.softmax(s, axis=-1).astype(v.dtype)
        return jnp.einsum('bhqk,bqkd->bqhd', pr, v_sel)

    out = lax.map(one_block, (jnp.arange(nb), blockify(q), blockify(q_idx), blockify(w_idx)))
    return jnp.moveaxis(out, 0, 1).reshape(Bn, S, H_B * HEAD_DIM)


def hybrid_layer(x, p_i, rope_h, rope_i, w_in, b_in, rel_bias, w_out, w_ple, w_pg, b_pg, ln_g, ln_b, topk):
    Bn, S, _ = x.shape
    cos_h, sin_h = rope_h
    cos_i, sin_i = rope_i
    proj = x @ w_in + b_in
    qa, ka, va, ga, qb, kb, vb, gb, qi, ki, wi = jnp.split(proj, SPLIT_IDX, axis=-1)
    ya = chunk_relpos_attention(qa.reshape(Bn, S, H_A, HEAD_DIM), ka.reshape(Bn, S, H_A, HEAD_DIM),
                                va.reshape(Bn, S, H_A, HEAD_DIM), rel_bias)
    qb = apply_rope(qb.reshape(Bn, S, H_B, HEAD_DIM), cos_h, sin_h)
    kb = apply_rope(kb.reshape(Bn, S, 1, HEAD_DIM), cos_h, sin_h).reshape(Bn, S, HEAD_DIM)
    qi = apply_rope(qi.reshape(Bn, S, H_IDX, D_IDX), cos_i, sin_i)
    ki = apply_rope(ki.reshape(Bn, S, 1, D_IDX), cos_i, sin_i).reshape(Bn, S, D_IDX)
    yb = indexed_sparse_attention(qb, kb, vb, qi, ki, wi, topk)
    y = jnp.concatenate([ya * jax.nn.silu(ga), yb * jax.nn.silu(gb)], axis=-1) @ w_out
    ple = jax.nn.sigmoid(x @ w_pg + b_pg) * (p_i @ w_ple)
    return layer_norm(ALPHA * x + y + ple, ln_g, ln_b)


def setup_inputs(seed: int = 0) -> dict:
    key = jax.random.key(seed)
    ks = jax.random.split(key, 14)
    f32 = jnp.float32
    x = jax.random.normal(ks[0], (BATCH, SEQ, D_MODEL), f32)
    p = jax.random.normal(ks[1], (DEPTH, BATCH, SEQ, D_PLE), f32)
    start = jax.random.randint(ks[2], (BATCH, 1), 0, 4096, dtype=jnp.int32)
    positions = start + jnp.arange(SEQ, dtype=jnp.int32)[None, :]
    col_scale = jnp.concatenate([jnp.full((n,), BETA if i in V_PARTS else 1.0, f32)
                                 for i, n in enumerate(SPLIT_SIZES)])
    w_in = jax.random.normal(ks[3], (DEPTH, D_MODEL, D_IN), f32) * (D_MODEL ** -0.5) * col_scale
    b_in = 0.01 * jax.random.normal(ks[4], (DEPTH, D_IN), f32)
    rel_bias = 0.2 * jax.random.normal(ks[5], (DEPTH, H_A, 2 * REL_CLIP + 1), f32)
    w_out = jax.random.normal(ks[6], (DEPTH, D_MIX, D_MODEL), f32) * (D_MIX ** -0.5) * BETA
    w_ple = jax.random.normal(ks[7], (DEPTH, D_PLE, D_MODEL), f32) * (D_PLE ** -0.5) * BETA
    w_ple_gate = jax.random.normal(ks[8], (DEPTH, D_MODEL, D_MODEL), f32) * (D_MODEL ** -0.5)
    b_ple_gate = 0.01 * jax.random.normal(ks[9], (DEPTH, D_MODEL), f32)
    ln_g = 1.0 + 0.02 * jax.random.normal(ks[10], (DEPTH, D_MODEL), f32)
    ln_b = 0.01 * jax.random.normal(ks[11], (DEPTH, D_MODEL), f32)
    return {'x': x, 'p': p, 'positions': positions, 'w_in': w_in, 'b_in': b_in, 'rel_bias': rel_bias,
            'w_out': w_out, 'w_ple': w_ple, 'w_ple_gate': w_ple_gate, 'b_ple_gate': b_ple_gate,
            'ln_g': ln_g, 'ln_b': ln_b}


def reference(x, p, positions, w_in, b_in, rel_bias, w_out, w_ple, w_ple_gate, b_ple_gate, ln_g, ln_b):
    S = x.shape[1]
    topk = min(TOPK_MAX, S // 4)
    rope_h = rope_tables(positions, HEAD_DIM)
    rope_i = rope_tables(positions, D_IDX)
    for i in range(DEPTH):
        x = hybrid_layer(x, p[i], rope_h, rope_i, w_in[i], b_in[i], rel_bias[i], w_out[i], w_ple[i],
                         w_ple_gate[i], b_ple_gate[i], ln_g[i], ln_b[i], topk)
    return x
```

```cpp
#include <hip/hip_runtime.h>
#include <hip/hip_cooperative_groups.h>
#include <cstdio>
#include <cstdint>
#include <cmath>
namespace cg = cooperative_groups;

#ifndef MK_N_LAUNCHES
#define MK_N_LAUNCHES 1
#endif

#ifndef PROBE_DUP
#define PROBE_DUP 0
#endif
#define LAS __attribute__((address_space(3)))
typedef unsigned short bf16_t;
typedef short bf16x8 __attribute__((ext_vector_type(8)));
typedef short s16x4 __attribute__((ext_vector_type(4)));
typedef float f32x4 __attribute__((ext_vector_type(4)));
typedef float f32x2 __attribute__((ext_vector_type(2)));
typedef float f32x16 __attribute__((ext_vector_type(16)));
typedef unsigned u32x4 __attribute__((ext_vector_type(4)));
typedef unsigned u32x2 __attribute__((ext_vector_type(2)));

constexpr int D_MODEL = 2048, BATCH = 4, SEQ = 2048, DEPTH = 4, CHUNK = 64, HD = 128, DPLE = 256;
constexpr int T = BATCH * SEQ;
constexpr int DIN = 6984;
constexpr int C_QA = 0, C_KA = 1024, C_VA = 2048, C_GA = 3072, C_QB = 4096, C_KB = 5120, C_VB = 5248, C_GB = 5376, C_QI = 6400, C_KI = 6912, C_WI = 6976;
constexpr int NCAT = 9216, WPITCH = D_MODEL + 64, PPITCH = DPLE + 64;
constexpr float ALPHA = 1.681792830507429f;
constexpr float LN_EPS = 1e-5f;
constexpr float SCALE = 0.088388347648318440f;
constexpr float NEGB = -1e30f;

constexpr size_t MiB = 1u << 20;
constexpr size_t WS_CTL = 0, CTL_BYTES = 1 * MiB;
constexpr size_t WS_WCAT = 1 * MiB;
constexpr size_t WS_WOUT = WS_WCAT + 152 * MiB;
constexpr size_t WS_WPLE = WS_WOUT + 34 * MiB;
constexpr size_t WS_PBF = WS_WPLE + 6 * MiB;
constexpr size_t WS_XB = WS_PBF + 16 * MiB;
constexpr size_t WS_XF = WS_XB + 32 * MiB;
constexpr size_t WS_QA = WS_XF + 64 * MiB;
constexpr size_t WS_KA = WS_QA + 16 * MiB, WS_VA = WS_KA + 16 * MiB, WS_SGA = WS_VA + 16 * MiB, WS_QB = WS_SGA + 16 * MiB, WS_SGB = WS_QB + 16 * MiB;
constexpr size_t WS_KB = WS_SGB + 16 * MiB;
constexpr size_t WS_VB = WS_KB + 2 * MiB;
constexpr size_t WS_QI = WS_VB + 2 * MiB;
constexpr size_t WS_KI = WS_QI + 8 * MiB;
constexpr size_t WS_WI = WS_KI + 1 * MiB;
constexpr size_t WS_GATE = WS_WI + 1 * MiB;
constexpr size_t WS_PLE = WS_GATE + 32 * MiB;
constexpr size_t WS_YMIX = WS_PLE + 32 * MiB;
constexpr size_t WS_COSH = WS_YMIX + 32 * MiB;
constexpr size_t WS_SINH = WS_COSH + 2 * MiB;
constexpr size_t WS_COSI = WS_SINH + 2 * MiB;
constexpr size_t WS_SINI = WS_COSI + 1 * MiB;
constexpr size_t WS_END = WS_SINI + 1 * MiB;
constexpr int CW_QUEUE = 64, CW_BAR = 4096;

static_assert((size_t)4 * NCAT * WPITCH * 2 <= 152 * MiB && (size_t)4 * D_MODEL * WPITCH * 2 <= 34 * MiB && (size_t)4 * D_MODEL * PPITCH * 2 <= 6 * MiB, "weight copies fit");
constexpr int RING_BYTES = 131072;
constexpr int L_WAVE = RING_BYTES;
constexpr int L_MASK = L_WAVE + 2048;
constexpr int L_BIAS = L_MASK + 8192;
constexpr int L_XCH = L_BIAS + 1280;
constexpr int L_CTL = L_XCH + 2048;
constexpr int LDS_BYTES = 147456;
static_assert(L_CTL + 64 <= LDS_BYTES, "LDS map");

struct InvTab { float h[64]; float i[32]; };
struct Args { const float* in[12]; float* out; unsigned char* ws; InvTab inv; int ph_lo, ph_hi, coop, pad; };

typedef __bf16 bf16x2_t __attribute__((ext_vector_type(2)));
__device__ __forceinline__ unsigned cvt_pk_bf16(float lo, float hi) { f32x2 v = {lo, hi}; bf16x2_t b = __builtin_convertvector(v, bf16x2_t); return __builtin_bit_cast(unsigned, b); }
__device__ __forceinline__ float bf2f(unsigned short b) { return __uint_as_float(((unsigned)b) << 16); }
__device__ __forceinline__ float bflo(unsigned w) { return __uint_as_float(w << 16); }
__device__ __forceinline__ float bfhi(unsigned w) { return __uint_as_float(w & 0xffff0000u); }

namespace pg8 {
constexpr int BM = 256, BK = 64, HALF = 128, HTB = HALF * BK * 2, STAGE_BYTES = 8 * HTB, NXCD = 8, WGM = 8;
__host__ __device__ __forceinline__ int lds_byte(int r, int c) { const int st = (r >> 4) * 2 + (c >> 5), rr = r & 15, cc = c & 31, ob = rr * 64 + cc * 2; return st * 1024 + (ob ^ (((ob >> 9) & 1) << 5)); }
__host__ __device__ __forceinline__ void stage_rc(int b, int& R, int& C) { const int st = b / 1024, sb = b % 1024, swz = sb ^ (((sb >> 9) & 1) << 5); R = (st >> 1) * 16 + swz / 64; C = (st & 1) * 32 + (swz % 64) / 2; }
__host__ __device__ __forceinline__ int perm32(int rho) { const int n = rho >> 4, i = rho & 15; return 8 * (i >> 2) + 4 * n + (i & 3); }
struct Unit { int pm, pn; };
struct Gemm { const bf16_t* A; const bf16_t* Bt; int M, N, K, ldb; };
struct StaticOrder {
    int nM, nN, nwg, G, c;
    __host__ __device__ void init(int M, int N, int G_, int c_) { nM = M / BM; nN = N / BM; nwg = nM * nN; G = G_; c = c_; }
    __host__ __device__ bool next(int i, Unit& u) const {
        const long L = (long)i * G + c; if (L >= nwg) return false;
        int wgid = (int)L; { const int q = nwg / NXCD, r = nwg % NXCD, xcd = wgid % NXCD, off = wgid / NXCD; wgid = (xcd < r ? xcd * (q + 1) : r * (q + 1) + (xcd - r) * q) + off; }
        const int nig = WGM * nN, gid = wgid / nig, fm = gid * WGM, gsz = (nM - fm) < WGM ? (nM - fm) : WGM;
        u.pm = fm + ((wgid % nig) % gsz); u.pn = (wgid % nig) / gsz; return true;
    }
    __device__ __forceinline__ void a_ready(const Unit&) const {}
    __device__ __forceinline__ void done(const Unit&) const {}
};

struct OneUnit {
    Unit u;
    __device__ __forceinline__ bool next(int i, Unit& o) const { if (i) return false; o = u; return true; }
    __device__ __forceinline__ void a_ready(const Unit&) const {}
    __device__ __forceinline__ void done(const Unit&) const {}
};

template <class Epi, class Sched, bool ALIGN_EPI = false, bool SP2 = false>
__device__ __forceinline__ void gemm_phase(LAS unsigned char* lds, const Gemm g, const Sched& S, const Epi& E) {
    int tid_ = threadIdx.x; asm volatile("" : "+v"(tid_));
    const int tid = tid_, wid = __builtin_amdgcn_readfirstlane(tid >> 6), lane = tid & 63, wr = wid >> 2, wc = wid & 3, fr = lane & 15, fq = lane >> 4;
    const int K = g.K, nt = K / BK;
    unsigned voffA[2], voffB[2];
#pragma unroll
    for (int i = 0; i < 2; ++i) { int R, C; stage_rc(tid * 16 + i * 8192, R, C); const int Rb = Epi::PERM ? ((R & ~31) + perm32(R & 31)) : R;
        voffA[i] = (unsigned)(R * K + C) * 2u; voffB[i] = (unsigned)(Rb * g.ldb + C) * 2u; }
    const size_t kstep = (size_t)(BK * 2);
    const size_t hstep = (size_t)HALF * K * 2, hstepB = (size_t)HALF * g.ldb * 2;
    const size_t tstep = 2 * hstep, tstepB = 2 * hstepB;
    const unsigned ldsw = (unsigned)wid * 1024u;
    const int aoff = lds_byte(wr * 64 + fr, fq * 8), boff = lds_byte(wc * 32 + fr, fq * 8);
#define PG8_SA(b, h) (((b) * 2 + (h)) * HTB)
#define PG8_SB(b, h) ((4 + (b) * 2 + (h)) * HTB)
#define PG8_STAGE(bufoff, gbase, voff) do { _Pragma("unroll") for (int _i = 0; _i < 2; ++_i) \
        __builtin_amdgcn_global_load_lds((const unsigned*)((const char*)(gbase) + (voff)[_i]), (LAS unsigned*)(lds + (bufoff) + ldsw + _i * 8192), 16, 0, 0); } while (0)
#define PG8_LDA(dst, b, h) do { _Pragma("unroll") for (int m = 0; m < 4; ++m) _Pragma("unroll") for (int k = 0; k < 2; ++k) dst[m][k] = *(const LAS bf16x8*)(lds + PG8_SA(b, h) + aoff + m * 2048 + k * 1024); } while (0)
#define PG8_LDB(dst, b, h) do { _Pragma("unroll") for (int n = 0; n < 2; ++n) _Pragma("unroll") for (int k = 0; k < 2; ++k) dst[n][k] = *(const LAS bf16x8*)(lds + PG8_SB(b, h) + boff + n * 2048 + k * 1024); } while (0)
#define PG8_MMA(ai, bj, At, Bt) do { __builtin_amdgcn_s_setprio(1); _Pragma("unroll") for (int m = 0; m < 4; ++m) _Pragma("unroll") for (int n = 0; n < 2; ++n) _Pragma("unroll") for (int k = 0; k < 2; ++k) \
        acc[ai][bj][m][n] = __builtin_amdgcn_mfma_f32_16x16x32_bf16(Bt[n][k], At[m][k], acc[ai][bj][m][n], 0, 0, 0); __builtin_amdgcn_s_setprio(0); } while (0)
#define PG8_WAIT_V(n) asm volatile("s_waitcnt vmcnt(" #n ")" ::: "memory")
#define PG8_WAIT_L(n) asm volatile("s_waitcnt lgkmcnt(" #n ")" ::: "memory")
#define PG8_BAR __builtin_amdgcn_s_barrier()
#define PG8_SCHED __builtin_amdgcn_sched_barrier(0)
    Unit cur, nxt; int ui = 0;
    if (!S.next(0, cur)) return;
    f32x4 acc[2][2][4][2];
#pragma unroll
    for (int a = 0; a < 2; ++a)
#pragma unroll
        for (int b = 0; b < 2; ++b)
#pragma unroll
            for (int m = 0; m < 4; ++m)
#pragma unroll
                for (int n = 0; n < 2; ++n) acc[a][b][m][n] = (f32x4){0.f, 0.f, 0.f, 0.f};
    bf16x8 At[4][2], B0[2][2], B1[2][2];
    const char* cA = (const char*)g.A + (size_t)cur.pm * tstep; const char* cB = (const char*)g.Bt + (size_t)cur.pn * tstepB;
    S.a_ready(cur);
    if constexpr (SP2) {
        PG8_STAGE(PG8_SB(0, 0), cB, voffB); PG8_STAGE(PG8_SB(0, 1), cB + hstepB, voffB); PG8_STAGE(PG8_SA(0, 0), cA, voffA); PG8_STAGE(PG8_SA(0, 1), cA + hstep, voffA);
        if (wr == 1) PG8_BAR;
        PG8_WAIT_V(2); PG8_BAR;
        PG8_STAGE(PG8_SB(1, 0), cB + kstep, voffB); PG8_STAGE(PG8_SA(1, 0), cA + kstep, voffA); PG8_STAGE(PG8_SB(1, 1), cB + hstepB + kstep, voffB);
        PG8_WAIT_V(6); PG8_BAR;
    } else {
        PG8_STAGE(PG8_SB(0, 0), cB, voffB); PG8_STAGE(PG8_SA(0, 0), cA, voffA); PG8_STAGE(PG8_SB(0, 1), cB + hstepB, voffB); PG8_STAGE(PG8_SA(0, 1), cA + hstep, voffA);
        if (wr == 1) PG8_BAR;
        PG8_WAIT_V(4); PG8_BAR;
        PG8_STAGE(PG8_SB(1, 0), cB + kstep, voffB); PG8_STAGE(PG8_SA(1, 0), cA + kstep, voffA); PG8_STAGE(PG8_SB(1, 1), cB + hstepB + kstep, voffB);
        PG8_WAIT_V(6); PG8_BAR;
    }
    for (;;) {
        const bool has_next = S.next(ui + 1, nxt);
        const char* nA = has_next ? (const char*)g.A + (size_t)nxt.pm * tstep : cA; const char* nB = has_next ? (const char*)g.Bt + (size_t)nxt.pn * tstepB : cB;
        for (int t = 0; t < nt; t += 2) {
            const bool last = (t == nt - 2);
            const char* a1 = cA + (size_t)(t + 1) * kstep;
            const char* a2 = last ? nA : cA + (size_t)(t + 2) * kstep; const char* b2 = last ? nB : cB + (size_t)(t + 2) * kstep;
            const char* a3 = a2 + kstep; const char* b3 = b2 + kstep;
            if (last && has_next) S.a_ready(nxt);
            if constexpr (SP2) {
            PG8_LDB(B0, 0, 0); PG8_LDB(B1, 0, 1); PG8_SCHED; PG8_LDA(At, 0, 0); PG8_STAGE(PG8_SA(1, 1), a1 + hstep, voffA);
            PG8_WAIT_V(8); PG8_WAIT_L(0); PG8_BAR; PG8_MMA(0, 0, At, B0); PG8_MMA(0, 1, At, B1); PG8_BAR; PG8_SCHED;
            PG8_LDA(At, 0, 1); PG8_STAGE(PG8_SB(0, 0), b2, voffB); PG8_STAGE(PG8_SB(0, 1), b2 + hstepB, voffB); PG8_STAGE(PG8_SA(0, 0), a2, voffA);
            PG8_WAIT_V(8); PG8_WAIT_L(0); PG8_BAR; PG8_MMA(1, 0, At, B0); PG8_MMA(1, 1, At, B1); PG8_BAR; PG8_SCHED;
            PG8_LDB(B0, 1, 0); PG8_LDB(B1, 1, 1); PG8_SCHED; PG8_LDA(At, 1, 0); PG8_STAGE(PG8_SA(0, 1), a2 + hstep, voffA);
            PG8_WAIT_V(8); PG8_WAIT_L(0); PG8_BAR; PG8_MMA(0, 0, At, B0); PG8_MMA(0, 1, At, B1); PG8_BAR; PG8_SCHED;
            PG8_LDA(At, 1, 1); PG8_STAGE(PG8_SB(1, 0), b3, voffB); PG8_STAGE(PG8_SB(1, 1), b3 + hstepB, voffB); PG8_STAGE(PG8_SA(1, 0), a3, voffA);
            PG8_WAIT_V(8); PG8_WAIT_L(0); PG8_BAR; PG8_MMA(1, 0, At, B0); PG8_MMA(1, 1, At, B1); PG8_BAR; PG8_SCHED;
            } else {
            PG8_LDB(B0, 0, 0); PG8_SCHED; PG8_LDA(At, 0, 0); PG8_STAGE(PG8_SA(1, 1), a1 + hstep, voffA);
            PG8_WAIT_L(8); PG8_BAR; PG8_WAIT_L(0); PG8_MMA(0, 0, At, B0); PG8_BAR; PG8_SCHED;
            PG8_LDB(B1, 0, 1); PG8_STAGE(PG8_SB(0, 0), b2, voffB);
            PG8_BAR; PG8_WAIT_L(0); PG8_MMA(0, 1, At, B1); PG8_BAR;
            PG8_LDA(At, 0, 1); PG8_STAGE(PG8_SA(0, 0), a2, voffA);
            PG8_BAR; PG8_WAIT_L(0); PG8_MMA(1, 0, At, B0); PG8_BAR; PG8_SCHED;
            PG8_STAGE(PG8_SB(0, 1), b2 + hstepB, voffB);
            PG8_WAIT_V(6); PG8_BAR; PG8_MMA(1, 1, At, B1); PG8_BAR;
            PG8_LDB(B0, 1, 0); PG8_SCHED; PG8_LDA(At, 1, 0); PG8_STAGE(PG8_SA(0, 1), a2 + hstep, voffA);
            PG8_WAIT_L(8); PG8_BAR; PG8_WAIT_L(0); PG8_MMA(0, 0, At, B0); PG8_BAR; PG8_SCHED;
            PG8_LDB(B1, 1, 1); PG8_STAGE(PG8_SB(1, 0), b3, voffB);
            PG8_BAR; PG8_WAIT_L(0); PG8_MMA(0, 1, At, B1); PG8_BAR;
            PG8_LDA(At, 1, 1); PG8_STAGE(PG8_SA(1, 0), a3, voffA);
            PG8_BAR; PG8_WAIT_L(0); PG8_MMA(1, 0, At, B0); PG8_BAR; PG8_SCHED;
            PG8_STAGE(PG8_SB(1, 1), b3 + hstepB, voffB);
            PG8_WAIT_V(6); PG8_BAR; PG8_MMA(1, 1, At, B1); PG8_BAR;
            }
        }
        if constexpr (ALIGN_EPI) { if (wr == 0) PG8_BAR; }
        E(acc, cur, wr, wc, fr, fq); if constexpr (Epi::IDEM) { if (PROBE_DUP == 13) E(acc, cur, wr, wc, fr, fq); } S.done(cur);
        if (!has_next) break;
#pragma unroll
        for (int a = 0; a < 2; ++a)
#pragma unroll
            for (int b = 0; b < 2; ++b)
#pragma unroll
                for (int m = 0; m < 4; ++m)
#pragma unroll
                    for (int n = 0; n < 2; ++n) acc[a][b][m][n] = (f32x4){0.f, 0.f, 0.f, 0.f};
        cur = nxt; cA = nA; cB = nB; ++ui;
        if constexpr (ALIGN_EPI) { if (wr == 1) PG8_BAR; }
    }
    PG8_WAIT_V(0);
    if constexpr (!ALIGN_EPI) { if (wr == 0) PG8_BAR; }
    PG8_BAR;
#undef PG8_SA
#undef PG8_SB
#undef PG8_STAGE
#undef PG8_LDA
#undef PG8_LDB
#undef PG8_MMA
#undef PG8_WAIT_V
#undef PG8_WAIT_L
#undef PG8_BAR
#undef PG8_SCHED
}
}

__device__ __forceinline__ float sigm_f(float g) { return __builtin_amdgcn_rcpf(1.f + __builtin_amdgcn_exp2f(g * -1.4426950408889634f)); }
__device__ __forceinline__ float silu_f(float g) { return g * sigm_f(g); }
__device__ __forceinline__ f32x4 ld4(const float* p) { return *(const f32x4*)p; }
__device__ __forceinline__ void st_bf8(bf16_t* p, f32x4 a, f32x4 b) { u32x4 w; w.x = cvt_pk_bf16(a[0], a[1]); w.y = cvt_pk_bf16(a[2], a[3]); w.z = cvt_pk_bf16(b[0], b[1]); w.w = cvt_pk_bf16(b[2], b[3]); *(u32x4*)p = w; }
__device__ __forceinline__ void st_bf4(bf16_t* p, f32x4 a) { u32x2 w; w.x = cvt_pk_bf16(a[0], a[1]); w.y = cvt_pk_bf16(a[2], a[3]); *(u32x2*)p = w; }

struct EpiProj {
    static constexpr bool PERM = true, IDEM = true;
    unsigned char* wsb; const float *b_in, *b_pg;
    template <int ACT> __device__ __forceinline__ void plain(const f32x4 (&acc)[2][2][4][2], int bj, int row0, bf16_t* dst, int ldc, int col, f32x4 b0, f32x4 b1) const {
#pragma unroll
        for (int ai = 0; ai < 2; ++ai)
#pragma unroll
            for (int m = 0; m < 4; ++m) {
                f32x4 v0 = acc[ai][bj][m][0] + b0, v1 = acc[ai][bj][m][1] + b1;
                if (ACT == 1) {
#pragma unroll
                    for (int j = 0; j < 4; ++j) { v0[j] = silu_f(v0[j]); v1[j] = silu_f(v1[j]); } }
                if (ACT == 2) {
#pragma unroll
                    for (int j = 0; j < 4; ++j) { v0[j] = sigm_f(v0[j]); v1[j] = sigm_f(v1[j]); } }
                st_bf8(dst + ((unsigned)(row0 + ai * 128 + m * 16) * (unsigned)ldc + col), v0, v1);
            }
    }
    template <int ACT> __device__ __forceinline__ void plain2(const f32x4 (&acc)[2][2][4][2], int row0, bf16_t* dst, int ldc, int col0, const float* bias) const {
        const f32x4 b00 = ld4(bias), b01 = ld4(bias + 4), b10 = ld4(bias + 128), b11 = ld4(bias + 132);
        plain<ACT>(acc, 0, row0, dst, ldc, col0, b00, b01); plain<ACT>(acc, 1, row0, dst, ldc, col0 + 128, b10, b11);
    }
    template <int HALFD> __device__ __forceinline__ void rope(const f32x4 (&acc)[2][2][4][2], int bj, int row0, bf16_t* dst, int ldc, int hcol, int d1, f32x4 b0, f32x4 b1, const float* ct, const float* st) const {
#pragma unroll
        for (int ai = 0; ai < 2; ++ai) {
            f32x4 c[4], s[4];
#pragma unroll
            for (int m = 0; m < 4; ++m) { const unsigned r = (unsigned)(row0 + ai * 128 + m * 16); c[m] = ld4(ct + (r * HALFD + d1)); s[m] = ld4(st + (r * HALFD + d1)); }
#pragma unroll
            for (int m = 0; m < 4; ++m) {
                const int r = row0 + ai * 128 + m * 16;
                const f32x4 t1 = acc[ai][bj][m][0] + b0, t2 = acc[ai][bj][m][1] + b1;
                const f32x4 o1 = t1 * c[m] - t2 * s[m], o2 = t2 * c[m] + t1 * s[m];
                st_bf4(dst + ((unsigned)r * (unsigned)ldc + hcol + d1), o1); st_bf4(dst + ((unsigned)r * (unsigned)ldc + hcol + HALFD + d1), o2);
            }
        }
    }
    __device__ __forceinline__ void operator()(const f32x4 (&acc)[2][2][4][2], const pg8::Unit& u, int wr, int wc, int fr, int fq) const {
        asm volatile("" : "+v"(fr), "+v"(fq));
        const int pn = u.pn, row0 = u.pm * 256 + wr * 64 + fr, lc = 32 * wc + 8 * fq;
        size_t w_z = 0; asm volatile("" : "+s"(w_z)); unsigned char* w = wsb + w_z;
        bf16_t* const QA = (bf16_t*)(w + WS_QA); bf16_t* const KA = (bf16_t*)(w + WS_KA); bf16_t* const VA = (bf16_t*)(w + WS_VA); bf16_t* const SGA = (bf16_t*)(w + WS_SGA);
        bf16_t* const QB = (bf16_t*)(w + WS_QB); bf16_t* const SGB = (bf16_t*)(w + WS_SGB); bf16_t* const KB = (bf16_t*)(w + WS_KB); bf16_t* const VB = (bf16_t*)(w + WS_VB);
        bf16_t* const QI = (bf16_t*)(w + WS_QI); bf16_t* const KI = (bf16_t*)(w + WS_KI); float* const WI = (float*)(w + WS_WI); bf16_t* const GATE = (bf16_t*)(w + WS_GATE);
        const float* const cosH = (const float*)(w + WS_COSH); const float* const sinH = (const float*)(w + WS_SINH); const float* const cosI = (const float*)(w + WS_COSI); const float* const sinI = (const float*)(w + WS_SINI);
        if (pn < 16) {
            const int seg = pn >> 2; bf16_t* dst = seg == 0 ? QA : seg == 1 ? KA : seg == 2 ? VA : SGA; const int col = (pn & 3) * 256 + lc;
            if (seg == 3) plain2<1>(acc, row0, dst, 1024, col, b_in + seg * 1024 + col); else plain2<0>(acc, row0, dst, 1024, col, b_in + seg * 1024 + col);
        } else if (pn < 20) {
            const int h0 = (pn - 16) * 2, d1 = 4 * (4 * wc + fq); const float* bb = b_in + C_QB + h0 * 128 + d1;
            const f32x4 b00 = ld4(bb), b01 = ld4(bb + 64), b10 = ld4(bb + 128), b11 = ld4(bb + 192);
            rope<64>(acc, 0, row0, QB, 1024, h0 * 128, d1, b00, b01, cosH, sinH); rope<64>(acc, 1, row0, QB, 1024, (h0 + 1) * 128, d1, b10, b11, cosH, sinH);
        } else if (pn < 24) {
            const int col = (pn - 20) * 256 + lc; plain2<1>(acc, row0, SGB, 1024, col, b_in + C_GB + col);
        } else if (pn == 24) {
            const int d1 = 4 * (4 * wc + fq);
            const f32x4 b00 = ld4(b_in + C_KB + d1), b01 = ld4(b_in + C_KB + 64 + d1), b10 = ld4(b_in + C_VB + lc), b11 = ld4(b_in + C_VB + lc + 4);
            rope<64>(acc, 0, row0, KB, 128, 0, d1, b00, b01, cosH, sinH);
            plain<0>(acc, 1, row0, VB, 128, lc, b10, b11);
        } else if (pn < 27) {
            const int h0 = (pn - 25) * 4 + (wc >> 1), d1 = 4 * ((4 * wc + fq) & 7); const float* bb = b_in + C_QI + h0 * 64 + d1;
            const f32x4 b00 = ld4(bb), b01 = ld4(bb + 32), b10 = ld4(bb + 128), b11 = ld4(bb + 160);
            rope<32>(acc, 0, row0, QI, 512, h0 * 64, d1, b00, b01, cosI, sinI); rope<32>(acc, 1, row0, QI, 512, (h0 + 2) * 64, d1, b10, b11, cosI, sinI);
        } else if (pn == 27) {
            if (wc < 2) { const int d1 = 4 * (4 * wc + fq); const f32x4 b00 = ld4(b_in + C_KI + d1), b01 = ld4(b_in + C_KI + 32 + d1); rope<32>(acc, 0, row0, KI, 64, 0, d1, b00, b01, cosI, sinI); }
            else if (wc == 2 && fq == 0) {
                const f32x4 b0 = ld4(b_in + C_WI), b1 = ld4(b_in + C_WI + 4); const float sc = 0.35355339059327373f * 0.125f;
#pragma unroll
                for (int ai = 0; ai < 2; ++ai)
#pragma unroll
                    for (int m = 0; m < 4; ++m) { float* p = WI + (size_t)(row0 + ai * 128 + m * 16) * 8; *(f32x4*)p = (acc[ai][0][m][0] + b0) * sc; *(f32x4*)(p + 4) = (acc[ai][0][m][1] + b1) * sc; }
            }
        } else {
            const int col = (pn - 28) * 256 + lc; plain2<2>(acc, row0, GATE, 2048, col, b_pg + col);
        }
    }
};
struct EpiPlain {
    static constexpr bool PERM = true, IDEM = false;
    bf16_t* O; int ldc;
    __device__ __forceinline__ void operator()(const f32x4 (&acc)[2][2][4][2], const pg8::Unit& u, int wr, int wc, int fr, int fq) const {
        asm volatile("" : "+v"(fr), "+v"(fq));
        const int row0 = u.pm * 256 + wr * 64 + fr;
#pragma unroll
        for (int bj = 0; bj < 2; ++bj) { const int col = u.pn * 256 + 128 * bj + 32 * wc + 8 * fq;
#pragma unroll
            for (int ai = 0; ai < 2; ++ai)
#pragma unroll
                for (int m = 0; m < 4; ++m) st_bf8(O + (size_t)(row0 + ai * 128 + m * 16) * ldc + col, acc[ai][bj][m][0], acc[ai][bj][m][1]); }
    }
};
struct EpiRes {
    static constexpr bool PERM = true, IDEM = false;
    const float* xres; unsigned char* wsb;
    __device__ __forceinline__ void operator()(const f32x4 (&acc)[2][2][4][2], const pg8::Unit& u, int wr, int wc, int fr, int fq) const {
        asm volatile("" : "+v"(fr), "+v"(fq));
        const int row0 = u.pm * 256 + wr * 64 + fr;
        size_t w_z = 0; asm volatile("" : "+s"(w_z)); unsigned char* w = wsb + w_z;
        float* const XF = (float*)(w + WS_XF); const bf16_t* const GATE = (const bf16_t*)(w + WS_GATE); const bf16_t* const PLE = (const bf16_t*)(w + WS_PLE);
#pragma unroll
        for (int ai = 0; ai < 2; ++ai)
#pragma unroll
            for (int m = 0; m < 4; ++m)
#pragma unroll
                for (int bj = 0; bj < 2; ++bj) {
                    const size_t off = (size_t)(row0 + ai * 128 + m * 16) * D_MODEL + u.pn * 256 + 128 * bj + 32 * wc + 8 * fq;
                    const f32x4 x0 = ld4(xres + off), x1 = ld4(xres + off + 4); const u32x4 gw = *(const u32x4*)(GATE + off), pw = *(const u32x4*)(PLE + off);
                    f32x4 h0, h1;
                    h0[0] = bflo(gw.x) * bflo(pw.x); h0[1] = bfhi(gw.x) * bfhi(pw.x); h0[2] = bflo(gw.y) * bflo(pw.y); h0[3] = bfhi(gw.y) * bfhi(pw.y);
                    h1[0] = bflo(gw.z) * bflo(pw.z); h1[1] = bfhi(gw.z) * bfhi(pw.z); h1[2] = bflo(gw.w) * bflo(pw.w); h1[3] = bfhi(gw.w) * bfhi(pw.w);
                    h0 = h0 + acc[ai][bj][m][0] + x0 * ALPHA; h1 = h1 + acc[ai][bj][m][1] + x1 * ALPHA;
                    *(f32x4*)(XF + off) = h0; *(f32x4*)(XF + off + 4) = h1;
                }
    }
};

#define KSWZ(row, colB) ((row) * 256 + ((colB) ^ (((row) & 7) << 4)))
#define SBAR() __builtin_amdgcn_sched_barrier(0)
__device__ __forceinline__ int crow(int r, int hi) { return (r & 3) + 8 * (r >> 2) + 4 * hi; }
constexpr float ATHR = 8.f;
__device__ __forceinline__ void partialSM(f32x16& p0, f32x16& p1, float& m_reg, float& mn, float& alpha) {
    constexpr float C = SCALE * 1.4426950408889634f;
    float pmax = p0[0];
#pragma unroll
    for (int r = 1; r < 16; ++r) pmax = fmaxf(pmax, p0[r]);
#pragma unroll
    for (int r = 0; r < 16; ++r) pmax = fmaxf(pmax, p1[r]);
    { auto rr = __builtin_amdgcn_permlane32_swap(__float_as_uint(pmax), __float_as_uint(pmax), false, false); pmax = fmaxf(__uint_as_float(rr[0]), __uint_as_float(rr[1])); }
    if (__builtin_expect(__all(pmax - m_reg <= ATHR / SCALE), 1)) { mn = m_reg; alpha = 1.f; }
    else { mn = fmaxf(m_reg, pmax); alpha = __builtin_amdgcn_exp2f((m_reg - mn) * C); m_reg = mn; }
    const float mnC = -mn * C;
#pragma unroll
    for (int r = 0; r < 16; ++r) p0[r] = fmaf(p0[r], C, mnC);
#pragma unroll
    for (int r = 0; r < 16; ++r) p1[r] = fmaf(p1[r], C, mnC);
#pragma unroll
    for (int r = 0; r < 16; ++r) p0[r] = __builtin_amdgcn_exp2f(p0[r]);
}
__device__ __forceinline__ void finishSM(f32x16& p0, f32x16& p1, float alpha, float& l_reg, bf16x8& pa0, bf16x8& pa1, bf16x8& pa2, bf16x8& pa3) {
#pragma unroll
    for (int r = 0; r < 16; ++r) p1[r] = __builtin_amdgcn_exp2f(p1[r]);
    float ps = 0;
#pragma unroll
    for (int r = 0; r < 16; ++r) ps += p0[r];
#pragma unroll
    for (int r = 0; r < 16; ++r) ps += p1[r];
    { auto rr = __builtin_amdgcn_permlane32_swap(__float_as_uint(ps), __float_as_uint(ps), false, false); ps = __uint_as_float(rr[0]) + __uint_as_float(rr[1]); }
    l_reg = l_reg * alpha + ps;
#define PK4(P, BASE, OUT) do { unsigned a0 = cvt_pk_bf16(P[BASE + 0], P[BASE + 1]), a1 = cvt_pk_bf16(P[BASE + 2], P[BASE + 3]);   \
    unsigned b0 = cvt_pk_bf16(P[BASE + 4], P[BASE + 5]), b1 = cvt_pk_bf16(P[BASE + 6], P[BASE + 7]);                              \
    auto r0 = __builtin_amdgcn_permlane32_swap(a0, b0, false, false); auto r1 = __builtin_amdgcn_permlane32_swap(a1, b1, false, false); \
    u32x4 w = {r0[0], r1[0], r0[1], r1[1]}; OUT = *reinterpret_cast<bf16x8*>(&w); } while (0)
    PK4(p0, 0, pa0); PK4(p0, 8, pa1); PK4(p1, 0, pa2); PK4(p1, 8, pa3);
#undef PK4
}
__device__ __forceinline__ void qkt(f32x16& p0, f32x16& p1, const LAS unsigned char* Ks, const bf16x8* qr, int r32, int hi, float init) {
#pragma unroll
    for (int r = 0; r < 16; ++r) { p0[r] = init; p1[r] = init; }
#pragma unroll
    for (int d0 = 0; d0 < 8; ++d0) { const int cb = (d0 * 16 + hi * 8) * 2;
        const bf16x8 b0 = *(const LAS bf16x8*)(Ks + KSWZ(r32, cb));
        const bf16x8 b1 = *(const LAS bf16x8*)(Ks + KSWZ(32 + r32, cb));
        p0 = __builtin_amdgcn_mfma_f32_32x32x16_bf16(b0, qr[d0], p0, 0, 0, 0);
        p1 = __builtin_amdgcn_mfma_f32_32x32x16_bf16(b1, qr[d0], p1, 0, 0, 0); }
}
__device__ __forceinline__ int v_st(int k, int c) { const int kk = (k & ~0xC) | ((k & 4) << 1) | ((k & 8) >> 1); return ((kk >> 3) * 4 + (c >> 5)) * 512 + ((kk & 7) * 32 + (c & 31)) * 2; }
__device__ __forceinline__ int v_rd_base(int lane) { return ((lane & 3) << 3) | (((lane >> 2) & 3) << 6) | (((lane >> 4) & 1) << 5) | (((lane >> 5) & 1) << 8); }
constexpr int v_rd_off(int d0, int ks, int half) { return d0 * 512 + ks * 4096 + half * 2048; }
template <int OFF> __device__ __forceinline__ s16x4 tr_read(int vb) { s16x4 r; asm volatile("ds_read_b64_tr_b16 %0, %1 offset:%2" : "=&v"(r) : "v"(vb), "i"(OFF) : "memory"); return r; }
template <int D0> __device__ __forceinline__ void pv_one(f32x16& od, int vb, bf16x8 pa0, bf16x8 pa1, bf16x8 pa2, bf16x8 pa3) {
    const s16x4 l0 = tr_read<v_rd_off(D0, 0, 0)>(vb), h0 = tr_read<v_rd_off(D0, 0, 1)>(vb), l1 = tr_read<v_rd_off(D0, 1, 0)>(vb), h1 = tr_read<v_rd_off(D0, 1, 1)>(vb);
    const s16x4 l2 = tr_read<v_rd_off(D0, 2, 0)>(vb), h2 = tr_read<v_rd_off(D0, 2, 1)>(vb), l3 = tr_read<v_rd_off(D0, 3, 0)>(vb), h3 = tr_read<v_rd_off(D0, 3, 1)>(vb);
    asm volatile("s_waitcnt lgkmcnt(0)" ::: "memory"); SBAR();
#define PKV(L, H) (bf16x8){L[0], L[1], L[2], L[3], H[0], H[1], H[2], H[3]}
    od = __builtin_amdgcn_mfma_f32_32x32x16_bf16(pa0, PKV(l0, h0), od, 0, 0, 0);
    od = __builtin_amdgcn_mfma_f32_32x32x16_bf16(pa1, PKV(l1, h1), od, 0, 0, 0);
    od = __builtin_amdgcn_mfma_f32_32x32x16_bf16(pa2, PKV(l2, h2), od, 0, 0, 0);
    od = __builtin_amdgcn_mfma_f32_32x32x16_bf16(pa3, PKV(l3, h3), od, 0, 0, 0);
#undef PKV
}
__device__ __forceinline__ void pv_d0(f32x16* o, int vb, bf16x8 pa0, bf16x8 pa1, bf16x8 pa2, bf16x8 pa3) {
    pv_one<0>(o[0], vb, pa0, pa1, pa2, pa3); pv_one<1>(o[1], vb, pa0, pa1, pa2, pa3); pv_one<2>(o[2], vb, pa0, pa1, pa2, pa3); pv_one<3>(o[3], vb, pa0, pa1, pa2, pa3);
}

__device__ __forceinline__ void dma_offsets(int wid, int lane, int ldk, unsigned (&ko)[2], unsigned (&vo)[2]) {
#pragma unroll
    for (int r = 0; r < 2; ++r) {
        const int G = r * 512 + wid * 64 + lane;
        const int row = G >> 4, slot = G & 15; ko[r] = (unsigned)(row * ldk + ((slot ^ (row & 7)) * 8)) * 2u;
        const int st = G >> 5, w_ = G & 31, kk = (st >> 2) * 8 + (w_ >> 2), c = (st & 3) * 32 + (w_ & 3) * 8, k = (kk & ~0xC) | ((kk & 4) << 1) | ((kk & 8) >> 1);
        vo[r] = (unsigned)(k * ldk + c) * 2u;
    }
}
#define ADMA(slot_, Kt, Vt) do { _Pragma("unroll") for (int _r = 0; _r < 2; ++_r) { \
        __builtin_amdgcn_global_load_lds((const unsigned*)((const char*)(Kt) + ko[_r]), (LAS unsigned*)(lds + (slot_) * 32768 + _r * 8192 + wid * 1024), 16, 0, 0); \
        __builtin_amdgcn_global_load_lds((const unsigned*)((const char*)(Vt) + vo[_r]), (LAS unsigned*)(lds + (slot_) * 32768 + 16384 + _r * 8192 + wid * 1024), 16, 0, 0); } } while (0)
#define RESC(a) do { if (__any((a) < 1.f)) { if (hi == 0) al_l[r32] = (a); asm volatile("s_waitcnt lgkmcnt(0)" ::: "memory"); \
    _Pragma("unroll") for (int d = 0; d < 4; ++d) _Pragma("unroll") for (int r = 0; r < 16; ++r) o[d][r] *= al_l[crow(r, hi)]; } } while (0)

__device__ __forceinline__ unsigned f2key(float f) { f = f + 0.0f; const unsigned u = __float_as_uint(f); return (u & 0x80000000u) ? ~u : (u | 0x80000000u); }
__device__ __forceinline__ unsigned wave_sum_u32(unsigned x) {
    x += (unsigned)__builtin_amdgcn_update_dpp(0, (int)x, 0xB1, 0xF, 0xF, true);
    x += (unsigned)__builtin_amdgcn_update_dpp(0, (int)x, 0x4E, 0xF, 0xF, true);
    x += (unsigned)__builtin_amdgcn_update_dpp(0, (int)x, 0x141, 0xF, 0xF, true);
    x += (unsigned)__builtin_amdgcn_update_dpp(0, (int)x, 0x140, 0xF, 0xF, true);
    return (unsigned)__builtin_amdgcn_readlane((int)x, 0) + (unsigned)__builtin_amdgcn_readlane((int)x, 16) + (unsigned)__builtin_amdgcn_readlane((int)x, 32) + (unsigned)__builtin_amdgcn_readlane((int)x, 48);
}
template <int NR> __device__ __forceinline__ void sel_write(const unsigned (&u)[NR], unsigned p, int n, LAS unsigned long long* M, int lane) {
    if (n == 256) {
#pragma unroll
        for (int i = 0; i < NR; ++i) { const unsigned long long m = __ballot(u[i] >= p); if (lane == 0) M[i] = m; }
    } else {
        int cgt = 0;
#pragma unroll
        for (int i = 0; i < NR; ++i) cgt += __popcll(__ballot(u[i] > p));
        int need = 256 - cgt;
#pragma unroll
        for (int i = 0; i < NR; ++i) {
            const unsigned long long mg = __ballot(u[i] > p); unsigned long long me = __ballot(u[i] == p);
            int ne = __popcll(me);
            while (ne > need) { me &= ~(1ull << (63 - __clzll((long long)me))); --ne; }
            need -= ne;
            if (lane == 0) M[i] = mg | me;
        }
    }
}
template <int NR> __device__ __forceinline__ void select2(const LAS float* SC, LAS unsigned long long* MASK, int q0, int m0, int lane, int ntile) {
    unsigned uA[NR], uB[NR];
#pragma unroll
    for (int i = 0; i < NR; ++i) { uA[i] = (i < ntile) ? f2key(SC[q0 * 2048 + 64 * i + lane]) : 0u; uB[i] = (i < ntile) ? f2key(SC[(q0 + 1) * 2048 + 64 * i + lane]) : 0u; }
    unsigned pA = 0, pB = 0; int nA = 1 << 20, nB = 1 << 20;
    for (int bit = 31; bit >= 0; --bit) {
        const unsigned cA = pA | (1u << bit), cB = pB | (1u << bit);
        unsigned c0 = 0, c1 = 0;
#pragma unroll
        for (int i = 0; i < NR; ++i) { c0 += (uA[i] >= cA) ? 1u : 0u; c1 += (uB[i] >= cB) ? 1u : 0u; }
        const unsigned c = wave_sum_u32(c0 | (c1 << 16));
        const int tA = (int)(c & 0xffffu), tB = (int)(c >> 16);
        if (tA >= 256) { pA = cA; nA = tA; }
        if (tB >= 256) { pB = cB; nB = tB; }
        if (nA == 256 && nB == 256) break;
    }
    sel_write<NR>(uA, pA, nA, MASK + m0 * 32, lane);
    sel_write<NR>(uB, pB, nB, MASK + (m0 + 1) * 32, lane);
}

template <int MODE> __device__ __forceinline__ void attn_unit(LAS unsigned char* lds, int b, int ia  , int ib  , unsigned char* w, const float* rel_bias) {
    int tid_ = threadIdx.x; asm volatile("" : "+v"(tid_));
    const int tid = tid_, wid = __builtin_amdgcn_readfirstlane(tid >> 6), lane = tid & 63, r32 = lane & 31, hi = lane >> 5;
    LAS float* al_l = (LAS float*)(lds + L_WAVE) + wid * 64; LAS float* li_l = al_l + 32;
    const size_t tokb = (size_t)b * SEQ;
    bf16_t* const YMIX = (bf16_t*)(w + WS_YMIX);
    int nsteps, kc0 = 0, cw = 0, qo = 0, ntile = 0, ldk;
    const bf16_t *Kg, *Vg, *Qw, *SG; size_t tok0; float cfar = 0.f;
    LAS float* tblx = (LAS float*)(lds + L_BIAS);
    LAS unsigned long long* MASK = (LAS unsigned long long*)(lds + L_MASK);
    if (MODE == 0) {
        const int h = ia, n0 = ib * 4; kc0 = n0 >= 8 ? n0 - 8 : 0; nsteps = n0 + 4 - kc0; cw = n0 + (wid >> 1); qo = 32 * (wid & 1) + r32; ldk = 1024;
        const float* rb = rel_bias + h * 257;
        for (int i = tid; i < 320; i += 512) tblx[i] = rb[i < 256 ? i : 256] * (1.f / SCALE);
        cfar = rb[256] * (1.f / SCALE);
        tok0 = tokb + n0 * 64 + 32 * wid;
        Qw = (const bf16_t*)(w + WS_QA) + (tok0 + r32) * 1024 + h * 128 + hi * 8;
        Kg = (const bf16_t*)(w + WS_KA) + (tokb + kc0 * 64) * 1024 + h * 128; Vg = (const bf16_t*)(w + WS_VA) + (tokb + kc0 * 64) * 1024 + h * 128;
        SG = (const bf16_t*)(w + WS_SGA) + h * 128;
    } else {
        const int t0 = ia * 32, c = t0 >> 6, V = 64 * (c + 1); ntile = c + 1; nsteps = ntile; ldk = 128;
        const bf16_t* const QI = (const bf16_t*)(w + WS_QI); const bf16_t* const KI = (const bf16_t*)(w + WS_KI); const float* const WI = (const float*)(w + WS_WI);
        LAS float* SC = (LAS float*)lds;
        for (int half = 0; half < 2; ++half) {
            const size_t tq0 = tokb + t0 + 16 * half;
            {
                bf16x8 af[4][4]; float wv[4][16];
                { const int rho = r32, b2 = (rho >> 2) & 1, b3 = (rho >> 3) & 1, b4 = (rho >> 4) & 1, tq = 2 * b2 + b4, hh = (rho & 3) + 4 * b3;
#pragma unroll
                  for (int g = 0; g < 4; ++g) { const bf16_t* qp = QI + (tq0 + 4 * g + tq) * 512 + hh * 64 + 8 * hi;
#pragma unroll
                      for (int kk = 0; kk < 4; ++kk) af[g][kk] = *(const bf16x8*)(qp + 16 * kk); } }
#pragma unroll
                for (int g = 0; g < 4; ++g)
#pragma unroll
                    for (int r = 0; r < 16; ++r) wv[g][r] = WI[(tq0 + 4 * g + 2 * hi + (r >> 3)) * 8 + (r & 7)];
                const int n32 = V / 32;
                bf16x8 bcur[4], bnxt[4];
                if (wid < n32) { const bf16_t* kq = KI + (tokb + 32 * wid + r32) * 64 + 8 * hi;
#pragma unroll
                    for (int kk = 0; kk < 4; ++kk) bcur[kk] = *(const bf16x8*)(kq + 16 * kk); }
                for (int jt = wid; jt < n32; jt += 8) {
                    if (jt + 8 < n32) { const bf16_t* kq = KI + (tokb + 32 * (jt + 8) + r32) * 64 + 8 * hi;
#pragma unroll
                        for (int kk = 0; kk < 4; ++kk) bnxt[kk] = *(const bf16x8*)(kq + 16 * kk); }
#pragma unroll
                    for (int g = 0; g < 4; ++g) {
                        f32x16 a;
#pragma unroll
                        for (int r = 0; r < 16; ++r) a[r] = 0.f;
#pragma unroll
                        for (int kk = 0; kk < 4; ++kk) a = __builtin_amdgcn_mfma_f32_32x32x16_bf16(af[g][kk], bcur[kk], a, 0, 0, 0);
                        float s0 = 0.f, s1 = 0.f;
#pragma unroll
                        for (int r = 0; r < 8; ++r) { s0 = fmaf(wv[g][r], fmaxf(a[r], 0.f), s0); s1 = fmaf(wv[g][8 + r], fmaxf(a[8 + r], 0.f), s1); }
                        SC[(4 * g + 2 * hi) * 2048 + 32 * jt + r32] = s0; SC[(4 * g + 2 * hi + 1) * 2048 + 32 * jt + r32] = s1;
                    }
#pragma unroll
                    for (int kk = 0; kk < 4; ++kk) bcur[kk] = bnxt[kk];
                }
            }
            __syncthreads();
            { const int q0 = 2 * wid, m0 = 16 * half + 2 * wid;
              if (V <= 256) { if (lane < 32) { MASK[m0 * 32 + lane] = (lane < ntile) ? ~0ull : 0ull; MASK[(m0 + 1) * 32 + lane] = (lane < ntile) ? ~0ull : 0ull; } }
              else if (ntile <= 8) select2<8>(SC, MASK, q0, m0, lane, ntile);
              else if (ntile <= 16) select2<16>(SC, MASK, q0, m0, lane, ntile);
              else if (ntile <= 24) select2<24>(SC, MASK, q0, m0, lane, ntile);
              else select2<32>(SC, MASK, q0, m0, lane, ntile); }
            __syncthreads();
        }
        tok0 = tokb + t0 + 4 * wid;
        Qw = (const bf16_t*)(w + WS_QB) + tok0 * 1024 + r32 * 128 + hi * 8;
        Kg = (const bf16_t*)(w + WS_KB) + tokb * 128; Vg = (const bf16_t*)(w + WS_VB) + tokb * 128;
        SG = (const bf16_t*)(w + WS_SGB);
    }
    float m_reg = -1e30f, l_reg = 0.f; f32x16 o[4];
#pragma unroll
    for (int d = 0; d < 4; ++d)
#pragma unroll
        for (int r = 0; r < 16; ++r) o[d][r] = 0.f;
    bf16x8 qr[8];
#pragma unroll
    for (int d0 = 0; d0 < 8; ++d0) qr[d0] = *(const bf16x8*)(Qw + d0 * 16);
    unsigned ko[2], vo[2]; dma_offsets(wid, lane, ldk, ko, vo);
    const size_t tstride = (size_t)64 * ldk * 2;
    asm volatile("s_waitcnt vmcnt(0) lgkmcnt(0)" ::: "memory"); __builtin_amdgcn_s_barrier(); asm volatile("" ::: "memory");
#pragma unroll
    for (int t = 0; t < 3; ++t) { const int tt = t < nsteps ? t : nsteps - 1; ADMA(t, (const char*)Kg + tt * tstride, (const char*)Vg + tt * tstride); }
    const int vb0 = (int)(uintptr_t)(lds + 16384) + v_rd_base(lane);
    const int ql = 4 * wid + (r32 >> 3);
    for (int s = 0; s < nsteps; ++s) {
        asm volatile("s_waitcnt vmcnt(8)" ::: "memory"); __builtin_amdgcn_s_barrier(); asm volatile("" ::: "memory");
        { const int tt = s + 3 < nsteps ? s + 3 : nsteps - 1; ADMA((s + 3) & 3, (const char*)Kg + tt * tstride, (const char*)Vg + tt * tstride); }
        const int slot = s & 3;
        bool active = true; int delta = 0;
        if (MODE == 0) { delta = cw - (kc0 + s); active = delta >= 0 && delta <= 8; }
        if (active) {
            f32x16 p0, p1; float mn, alpha; bf16x8 pa0, pa1, pa2, pa3;
            qkt(p0, p1, lds + slot * 32768, qr, r32, hi, (MODE == 0 && delta >= 3) ? cfar : 0.f);
            if (MODE == 0) {
                if (delta < 3) {
                    const LAS float* tb = tblx + (64 * delta + qo + 128 - 4 * hi - 63);
#pragma unroll
                    for (int r = 0; r < 16; ++r) { const int kk = (r & 3) + 8 * (r >> 2); p0[r] += tb[63 - kk]; p1[r] += tb[63 - kk - 32]; }
                }
            } else {
                const unsigned long long mw = MASK[ql * 32 + s]; const unsigned m0 = (unsigned)mw >> (4 * hi), m1 = (unsigned)(mw >> 32) >> (4 * hi);
#pragma unroll
                for (int r = 0; r < 16; ++r) { const unsigned bit = 1u << ((r & 3) + 8 * (r >> 2)); p0[r] = (m0 & bit) ? p0[r] : NEGB; p1[r] = (m1 & bit) ? p1[r] : NEGB; }
            }
            if (PROBE_DUP == 10) { f32x16 q0, q1; qkt(q0, q1, lds + slot * 32768, qr, r32, hi, 0.f); asm volatile("" :: "v"(q0), "v"(q1)); }
            if (PROBE_DUP == 11) { f32x16 q0 = p0, q1 = p1; float m2 = m_reg, l2 = l_reg, mn2, al2; bf16x8 qa0, qa1, qa2, qa3; asm volatile("" : "+v"(q0), "+v"(q1));
                partialSM(q0, q1, m2, mn2, al2); finishSM(q0, q1, al2, l2, qa0, qa1, qa2, qa3); asm volatile("" :: "v"(qa0), "v"(qa1), "v"(qa2), "v"(qa3), "v"(l2), "v"(m2)); }
            partialSM(p0, p1, m_reg, mn, alpha);
            RESC(alpha);
            finishSM(p0, p1, alpha, l_reg, pa0, pa1, pa2, pa3); SBAR();
            pv_d0(o, vb0 + slot * 32768, pa0, pa1, pa2, pa3);
            if (PROBE_DUP == 12) { f32x16 o2[2]; o2[0] = o[0]; o2[1] = o[1]; asm volatile("" : "+v"(o2[0]), "+v"(o2[1]));
                pv_one<0>(o2[0], vb0 + slot * 32768, pa0, pa1, pa2, pa3); pv_one<1>(o2[1], vb0 + slot * 32768, pa0, pa1, pa2, pa3); pv_one<2>(o2[0], vb0 + slot * 32768, pa0, pa1, pa2, pa3); pv_one<3>(o2[1], vb0 + slot * 32768, pa0, pa1, pa2, pa3);
                asm volatile("" :: "v"(o2[0]), "v"(o2[1])); }
        }
    }
    asm volatile("s_waitcnt vmcnt(0)" ::: "memory"); __builtin_amdgcn_s_barrier(); asm volatile("" ::: "memory");
    if (hi == 0) li_l[r32] = l_reg; asm volatile("s_waitcnt lgkmcnt(0)" ::: "memory");
    float gv[16][4];
#pragma unroll
    for (int r = 0; r < 16; ++r) { const int orow = crow(r, hi);
        const size_t goff = (MODE == 0) ? (tok0 + orow) * 1024 : (tok0 + (orow >> 3)) * 1024 + (orow & 7) * 128;
#pragma unroll
        for (int d0 = 0; d0 < 4; ++d0) gv[r][d0] = bf2f(SG[goff + d0 * 32 + r32]); }
#pragma unroll
    for (int r = 0; r < 16; ++r) { const int orow = crow(r, hi); const float rl = __builtin_amdgcn_rcpf(li_l[orow]);
        const size_t yoff = (MODE == 0) ? (tok0 + orow) * 2048 + ia * 128 : (tok0 + (orow >> 3)) * 2048 + 1024 + (orow & 7) * 128;
#pragma unroll
        for (int d0 = 0; d0 < 4; ++d0) YMIX[yoff + d0 * 32 + r32] = (bf16_t)(cvt_pk_bf16(o[d0][r] * rl * gv[r][d0], 0.f) & 0xffffu); }
    __syncthreads();
}

__device__ __forceinline__ unsigned f2bf(float f) { unsigned u = __float_as_uint(f); return (u + 0x7fffu + ((u >> 16) & 1u)) >> 16; }
__device__ __forceinline__ unsigned pk2(float lo, float hi) { return f2bf(lo) | (f2bf(hi) << 16); }
__device__ __forceinline__ int cat_src(int ns, int& col) {
    if (ns < 4096) { col = ns; return 0; }
    if (ns < 5120) { const int l = ns - 4096, head = l >> 7, s = l & 127, g = s >> 3, j = s & 7; col = C_QB + head * 128 + 4 * g + (j & 3) + 64 * (j >> 2); return 0; }
    if (ns < 6144) { col = C_GB + (ns - 5120); return 0; }
    if (ns < 6272) { const int s = ns - 6144, g = s >> 3, j = s & 7; col = C_KB + 4 * g + (j & 3) + 64 * (j >> 2); return 0; }
    if (ns < 6400) { col = C_VB + (ns - 6272); return 0; }
    if (ns < 6912) { const int l = ns - 6400, head = l >> 6, s = l & 63, g = s >> 3, j = s & 7; col = C_QI + head * 64 + 4 * g + (j & 3) + 32 * (j >> 2); return 0; }
    if (ns < 6976) { const int s = ns - 6912, g = s >> 3, j = s & 7; col = C_KI + 4 * g + (j & 3) + 32 * (j >> 2); return 0; }
    if (ns < 6984) { col = ns; return 0; }
    if (ns < 7168) { col = 0; return -1; }
    col = ns - 7168; return 1;
}
template <bool CAT> __device__ __forceinline__ void p0_cvt_task(const float* W, const float* W2, int K  , int N, bf16_t* WT, int nb, int k0, int klen, int lane) {
    const float* src = W; int col = nb * 64 + lane, ld = N; float msk = 1.f;
    if (CAT) { const int m = cat_src(nb * 64 + lane, col); if (m == 1) { src = W2; ld = D_MODEL; } else if (m < 0) { msk = 0.f; ld = DIN; } else ld = DIN; }
    const float* p = src + (size_t)k0 * ld + col;
    bf16_t* q = WT + (size_t)(nb * 64 + lane) * K + k0;
    for (int k = 0; k < klen; k += 64) {
        float v[64];
#pragma unroll
        for (int i = 0; i < 64; ++i) { v[i] = *p; p += ld; asm volatile("" : "+v"(p)); }
#pragma unroll
        for (int c = 0; c < 8; ++c) { u32x4 o; o.x = cvt_pk_bf16(v[8 * c + 0] * msk, v[8 * c + 1] * msk); o.y = cvt_pk_bf16(v[8 * c + 2] * msk, v[8 * c + 3] * msk);
            o.z = cvt_pk_bf16(v[8 * c + 4] * msk, v[8 * c + 5] * msk); o.w = cvt_pk_bf16(v[8 * c + 6] * msk, v[8 * c + 7] * msk);
            *(u32x4*)(q + k + 8 * c) = o; }
    }
}
__device__ __forceinline__ float wave_sum(float v) {
#pragma unroll
    for (int o = 1; o < 64; o <<= 1) v += __shfl_xor(v, o);
    return v;
}


#define XB_TMO      128
#define XB_XCNT(j)  (256  + 64 * (j))
#define XB_XSUB(j)  (1280 + 64 * (j))
#define XB_XGEN(j)  (2304 + 64 * (j))
#define XB_TOP      3328
#define XB_TOPGEN   3392
#define XCD_BAR_WORDS 3456
#define XB_SPIN_CAP (1u << 18)
__device__ __forceinline__ unsigned xb_ld(unsigned* p)              { return __hip_atomic_load(p, __ATOMIC_RELAXED, __HIP_MEMORY_SCOPE_AGENT); }
__device__ __forceinline__ unsigned xb_add(unsigned* p, unsigned v) { return __hip_atomic_fetch_add(p, v, __ATOMIC_RELAXED, __HIP_MEMORY_SCOPE_AGENT); }
__device__ __forceinline__ unsigned xb_xcc_id() { return (unsigned)__builtin_amdgcn_s_getreg((3 << 11) | 20) & 0xFu; }
#define XB_SPIN(cond, bar) do { unsigned _sp = 0; while (cond) { __builtin_amdgcn_s_sleep(1); \
    if ((++_sp & 255u) == 0u) { if (xb_ld(&(bar)[XB_TMO])) break; if (_sp > XB_SPIN_CAP) { atomicAdd(&(bar)[XB_TMO], 1u); break; } } } } while (0)
struct XcdBarrier { unsigned* bar; unsigned x; volatile LAS unsigned* st; };
__device__ __forceinline__ XcdBarrier xcd_barrier_post(unsigned* bar, volatile LAS unsigned* st) {
    XcdBarrier b; b.bar = bar; b.x = xb_xcc_id(); b.st = st;
    if (threadIdx.x == 0) (void)xb_add(&bar[XB_XCNT(b.x)], 1u);
    return b;
}
__device__ __forceinline__ void xcd_barrier_complete(unsigned* bar, unsigned x, unsigned& nloc, unsigned& nx) {
    const unsigned G = gridDim.x * gridDim.y * gridDim.z;
    unsigned sum, cnt, mine, sp = 0u;
    for (;;) {
        sum = 0u; cnt = 0u; mine = 0u;
#pragma unroll
        for (unsigned j = 0; j < 16; ++j) { const unsigned c = xb_ld(&bar[XB_XCNT(j)]); sum += c; cnt += (c > 0u) ? 1u : 0u; mine = (j == x) ? c : mine; }
        if (sum == G) break;
        __builtin_amdgcn_s_sleep(1);
        if ((++sp & 255u) == 0u) { if (xb_ld(&bar[XB_TMO])) break; if (sp > XB_SPIN_CAP) { atomicAdd(&bar[XB_TMO], 1u); break; } }
    }
    nloc = mine > 0u ? mine : 1u; nx = cnt > 0u ? cnt : 1u;
}
__device__ __forceinline__ void xcd_barrier(const XcdBarrier& b) {
    asm volatile("s_waitcnt vmcnt(0)" ::: "memory");
    __syncthreads();
    if (threadIdx.x == 0) {
        size_t bz_ = 0; asm volatile("" : "+s"(bz_)); unsigned* bar = b.bar + bz_;
        __builtin_amdgcn_s_waitcnt(0);
        unsigned nloc = b.st[0], nx = b.st[1];
        if (nloc == 0u) { xcd_barrier_complete(bar, b.x, nloc, nx); b.st[0] = nloc; b.st[1] = nx; }
        const unsigned old = xb_add(&bar[XB_XSUB(b.x)], 1u);
        const unsigned gen = old / nloc;
        if (old + 1u == (gen + 1u) * nloc) {
            __builtin_amdgcn_fence(__ATOMIC_RELEASE, "agent");
            asm volatile("s_waitcnt vmcnt(0)" ::: "memory");
            const unsigned og = xb_add(&bar[XB_TOP], 1u);
            const unsigned tg = og / nx;
            if (og + 1u == (tg + 1u) * nx) xb_add(&bar[XB_TOPGEN], 1u);
            else XB_SPIN(xb_ld(&bar[XB_TOPGEN]) == tg, bar);
            __builtin_amdgcn_fence(__ATOMIC_ACQUIRE, "agent");
            xb_add(&bar[XB_XGEN(b.x)], 1u);
            asm volatile("s_waitcnt vmcnt(0)" ::: "memory");
        } else {
            XB_SPIN(xb_ld(&bar[XB_XGEN(b.x)]) == gen, bar);
            __builtin_amdgcn_fence(__ATOMIC_ACQUIRE, "agent");
            asm volatile("s_waitcnt vmcnt(0)" ::: "memory");
        }
    }
    __syncthreads();
}

__global__ void __launch_bounds__(512, 2) mk_fwd(Args args) {
    extern __shared__ __attribute__((aligned(16))) unsigned char lds_raw[];
    LAS unsigned char* lds = (LAS unsigned char*)lds_raw;
    const int G = gridDim.x, bx = blockIdx.x;
#define TID_OPAQUE() int tid_ = threadIdx.x; asm volatile("" : "+v"(tid_)); const int tid = tid_, lane = tid & 63, wave = __builtin_amdgcn_readfirstlane(tid >> 6); (void)lane; (void)wave
    unsigned char* ws = args.ws;
#define WSB(name) size_t name##_z = 0; asm volatile("" : "+s"(name##_z)); unsigned char* name = ws + name##_z
    const int lo = args.ph_lo, hi_ph = args.ph_hi;
#define IN(k) (lo <= (k) && (k) < hi_ph)
#define GRID_SYNC(k) do { if (IN(k) && IN((k) + 1)) { xcd_barrier(xbar); } } while (0)
    { volatile LAS unsigned* lc = (volatile LAS unsigned*)(lds + L_CTL); if (threadIdx.x < 16) lc[threadIdx.x] = 0u; }
    __syncthreads();
    if (args.coop == 2) cg::this_grid().sync();
    XcdBarrier xbar = xcd_barrier_post((unsigned*)(ws + WS_CTL) + CW_BAR, (volatile LAS unsigned*)(lds + L_CTL + 16));

    for (int rep = 0; rep < (PROBE_DUP == 1 ? 2 : 1); ++rep)
    if (IN(0)) {
        TID_OPAQUE(); WSB(w);
        const float* x_in = args.in[0]; const float* p_in = args.in[1]; const int* pos = (const int*)args.in[2];
        const float* w_in = args.in[3]; const float* w_out = args.in[6]; const float* w_ple = args.in[7]; const float* w_pg = args.in[8];
        bf16_t* WCAT = (bf16_t*)(w + WS_WCAT); bf16_t* WOUT = (bf16_t*)(w + WS_WOUT); bf16_t* WPLE = (bf16_t*)(w + WS_WPLE); bf16_t* PBF = (bf16_t*)(w + WS_PBF); bf16_t* XB = (bf16_t*)(w + WS_XB);
        float* COSH = (float*)(w + WS_COSH); float* SINH = (float*)(w + WS_SINH); float* COSI = (float*)(w + WS_COSI); float* SINI = (float*)(w + WS_SINI);
        const int gw = bx * 8 + wave, NGW = G * 8;
        constexpr int KT = 256;
        constexpr int I_CAT = (NCAT / 64) * (D_MODEL / KT), I_OUT = (D_MODEL / 64) * (D_MODEL / KT), I_PLE = (D_MODEL / 64) * (DPLE / KT), I_L = I_CAT + I_OUT + I_PLE;
#pragma nounroll
        for (int rep2 = 0; rep2 < (PROBE_DUP == 8 ? 2 : 1); ++rep2)
        for (int it = gw; it < DEPTH * I_L; it += NGW) {
            const int l = it / I_L; int r = it % I_L;
            if (r < I_CAT) { p0_cvt_task<true>(w_in + (size_t)l * D_MODEL * DIN, w_pg + (size_t)l * D_MODEL * D_MODEL, WPITCH, NCAT, WCAT + (size_t)l * NCAT * WPITCH, r % (NCAT / 64), (r / (NCAT / 64)) * KT, KT, lane); continue; }
            r -= I_CAT;
            if (r < I_OUT) { p0_cvt_task<false>(w_out + (size_t)l * D_MODEL * D_MODEL, nullptr, WPITCH, D_MODEL, WOUT + (size_t)l * D_MODEL * WPITCH, r % (D_MODEL / 64), (r / (D_MODEL / 64)) * KT, KT, lane); continue; }
            r -= I_OUT;
            p0_cvt_task<false>(w_ple + (size_t)l * DPLE * D_MODEL, nullptr, PPITCH, D_MODEL, WPLE + (size_t)l * D_MODEL * PPITCH, r % (D_MODEL / 64), (r / (D_MODEL / 64)) * KT, KT, lane);
        }
        const size_t gt = (size_t)bx * 512 + tid, NT_ = (size_t)G * 512;
#pragma nounroll
        for (int rep3 = 0; rep3 < (PROBE_DUP == 9 ? 2 : 1); ++rep3) {
        for (size_t i = gt; i < (size_t)T * D_MODEL / 8; i += 4 * NT_) {
            f32x4 a[4], c[4];
#pragma unroll
            for (int u = 0; u < 4; ++u) if (i + u * NT_ < (size_t)T * D_MODEL / 8) { a[u] = ld4(x_in + (i + u * NT_) * 8); c[u] = ld4(x_in + (i + u * NT_) * 8 + 4); }
#pragma unroll
            for (int u = 0; u < 4; ++u) if (i + u * NT_ < (size_t)T * D_MODEL / 8) st_bf8(XB + (i + u * NT_) * 8, a[u], c[u]);
        }
        for (size_t i = gt; i < (size_t)DEPTH * T * DPLE / 8; i += 4 * NT_) {
            f32x4 a[4], c[4];
#pragma unroll
            for (int u = 0; u < 4; ++u) if (i + u * NT_ < (size_t)DEPTH * T * DPLE / 8) { a[u] = ld4(p_in + (i + u * NT_) * 8); c[u] = ld4(p_in + (i + u * NT_) * 8 + 4); }
#pragma unroll
            for (int u = 0; u < 4; ++u) if (i + u * NT_ < (size_t)DEPTH * T * DPLE / 8) st_bf8(PBF + (i + u * NT_) * 8, a[u], c[u]);
        }
        for (unsigned i = (unsigned)gt; i < (unsigned)T * 96u; i += (unsigned)NT_) {
            const unsigned tok = i / 96u, j = i - tok * 96u; const float pf = (float)pos[tok];
            const float ang = pf * (j < 64u ? args.inv.h[j] : args.inv.i[j - 64u]);
            double tt = (double)ang * 0.15915494309189533577; tt -= rint(tt);
            const float r = (float)(tt * 6.28318530717958647692);
            float sv, cv; sincosf(r, &sv, &cv);
            if (j < 64u) { COSH[tok * 64u + j] = cv; SINH[tok * 64u + j] = sv; } else { COSI[tok * 32u + (j - 64u)] = cv; SINI[tok * 32u + (j - 64u)] = sv; }
        }
        }
    }
    GRID_SYNC(0);

    for (int l = 0; l < DEPTH; ++l) {
        const int pb = 1 + 4 * l;
        for (int rep = 0; rep < (PROBE_DUP == 2 ? 2 : 1); ++rep)
        if (IN(pb)) {
            { WSB(w); pg8::Gemm g{(const bf16_t*)(w + WS_XB), (const bf16_t*)(w + WS_WCAT) + (size_t)l * NCAT * WPITCH, T, 8192, D_MODEL, WPITCH}; pg8::StaticOrder S; S.init(T, 8192, G, bx);
              EpiProj E{ws, args.in[4] + (size_t)l * DIN, args.in[9] + (size_t)l * D_MODEL};
              pg8::gemm_phase<EpiProj, pg8::StaticOrder, true, true>(lds, g, S, E); }
        }
        GRID_SYNC(pb);
        for (int rep = 0; rep < (PROBE_DUP == 3 ? 2 : 1); ++rep)
        if (IN(pb + 1)) {
            TID_OPAQUE(); LAS int* bc = (LAS int*)(lds + L_CTL);
            WSB(w); unsigned* head = (unsigned*)(w + WS_CTL) + CW_QUEUE + 64 * (l + 4 * rep);
            for (;;) {
                __syncthreads();
                if (tid == 0) bc[0] = (int)__hip_atomic_fetch_add(head, 1u, __ATOMIC_RELAXED, __HIP_MEMORY_SCOPE_AGENT);
                __syncthreads();
                const int it = bc[0];
                if (it >= 896) break;
                if (it < 128) {
                    pg8::Gemm g{(const bf16_t*)(w + WS_XB), (const bf16_t*)(w + WS_WCAT) + (size_t)l * NCAT * WPITCH, T, NCAT, D_MODEL, WPITCH}; pg8::OneUnit S; S.u.pm = it & 31; S.u.pn = 32 + (it >> 5);
                    EpiProj E{ws, args.in[4] + (size_t)l * DIN, args.in[9] + (size_t)l * D_MODEL};
                    pg8::gemm_phase<EpiProj, pg8::OneUnit, false, true>(lds, g, S, E);
                    continue;
                }
                if (it >= 640) {
                    const int k = it - 640;
                    pg8::Gemm g{(const bf16_t*)(w + WS_PBF) + (size_t)l * T * DPLE, (const bf16_t*)(w + WS_WPLE) + (size_t)l * D_MODEL * PPITCH, T, D_MODEL, DPLE, PPITCH}; pg8::OneUnit S; S.u.pm = k & 31; S.u.pn = k >> 5;
                    EpiPlain E{(bf16_t*)(w + WS_PLE), D_MODEL};
                    pg8::gemm_phase<EpiPlain, pg8::OneUnit, false, true>(lds, g, S, E);
                    continue;
                }
                const int it2 = it - 128;
                int isB, cidx, sub;
                if (it2 < 192) { isB = 1; cidx = 31 - (it2 >> 3); sub = it2 & 7; }
                else if (it2 < 384) { isB = 0; const int k = it2 - 192; cidx = 2 + k / 32; sub = k % 32; }
                else if (it2 < 416) { isB = 1; const int k = it2 - 384; cidx = 7 - (k >> 3); sub = k & 7; }
                else if (it2 < 448) { isB = 0; cidx = 1; sub = it2 - 416; }
                else if (it2 < 480) { isB = 1; const int k = it2 - 448; cidx = 3 - (k >> 3); sub = k & 7; }
                else { isB = 0; cidx = 0; sub = it2 - 480; }
                if (isB) { attn_unit<1>(lds, sub >> 1, cidx * 2 + (sub & 1), 0, w, nullptr); if (PROBE_DUP == 5) attn_unit<1>(lds, sub >> 1, cidx * 2 + (sub & 1), 0, w, nullptr); }
                else { attn_unit<0>(lds, sub >> 3, sub & 7, cidx, w, args.in[5] + (size_t)l * 8 * 257); if (PROBE_DUP == 4) attn_unit<0>(lds, sub >> 3, sub & 7, cidx, w, args.in[5] + (size_t)l * 8 * 257); }
            }
        }
        GRID_SYNC(pb + 1);
        if (IN(pb + 2)) {
            WSB(w); pg8::Gemm g{(const bf16_t*)(w + WS_YMIX), (const bf16_t*)(w + WS_WOUT) + (size_t)l * D_MODEL * WPITCH, T, D_MODEL, D_MODEL, WPITCH}; pg8::StaticOrder S; S.init(T, D_MODEL, G, bx);
            EpiRes E{(l == 0) ? args.in[0] : (const float*)(w + WS_XF), ws};
            pg8::gemm_phase<EpiRes, pg8::StaticOrder, true, true>(lds, g, S, E);
        }
        GRID_SYNC(pb + 2);
        if (IN(pb + 3)) {
            TID_OPAQUE(); WSB(w); float* XF = (float*)(w + WS_XF); bf16_t* XB = (bf16_t*)(w + WS_XB);
            const int gw = bx * 8 + wave, NGW = G * 8;
            const float* gg = args.in[10] + (size_t)l * D_MODEL; const float* bb = args.in[11] + (size_t)l * D_MODEL;
            float* dstf = (l == DEPTH - 1) ? args.out : XF;
            for (int m = gw; m < T; m += NGW) {
                const float* xr = XF + (size_t)m * D_MODEL + 4 * lane;
                f32x4 v[8]; float s = 0.f;
#pragma unroll
                for (int j = 0; j < 8; ++j) { v[j] = ld4(xr + 256 * j); s += (v[j][0] + v[j][1]) + (v[j][2] + v[j][3]); }
                const float mean = wave_sum(s) * (1.f / D_MODEL); float s2 = 0.f;
#pragma unroll
                for (int j = 0; j < 8; ++j) { v[j] = v[j] - mean; s2 += (v[j][0] * v[j][0] + v[j][1] * v[j][1]) + (v[j][2] * v[j][2] + v[j][3] * v[j][3]); }
                const float rstd = 1.f / sqrtf(wave_sum(s2) * (1.f / D_MODEL) + LN_EPS);
#pragma unroll
                for (int j = 0; j < 8; ++j) { const f32x4 gv = ld4(gg + 4 * lane + 256 * j), bv = ld4(bb + 4 * lane + 256 * j); const f32x4 y = v[j] * rstd * gv + bv;
                    *(f32x4*)(dstf + (size_t)m * D_MODEL + 4 * lane + 256 * j) = y;
                    if (l != DEPTH - 1) st_bf4(XB + (size_t)m * D_MODEL + 4 * lane + 256 * j, y); }
            }
        }
        if (l != DEPTH - 1) GRID_SYNC(pb + 3);
    }
#undef IN
#undef GRID_SYNC
}

extern "C" void kernel_launch(void* const* d_in, const int* in_sizes, int n_in, void* d_out, int out_size, void* d_ws, size_t ws_size, hipStream_t stream) {
    static int grid = 0;
    if (grid == 0) {
        if (n_in != 12 || out_size != T * D_MODEL || ws_size < WS_END) { fprintf(stderr, "kernel_launch: unexpected shapes n_in %d out %d ws %zu (need %zu)\n", n_in, out_size, ws_size, (size_t)WS_END); grid = -1; return; }
        int dev = 0, cus = 0, per_cu = 0;
        hipGetDevice(&dev); hipDeviceGetAttribute(&cus, hipDeviceAttributeMultiprocessorCount, dev);
        if (hipFuncSetAttribute((const void*)mk_fwd, hipFuncAttributeMaxDynamicSharedMemorySize, LDS_BYTES) != hipSuccess) { fprintf(stderr, "kernel_launch: hipFuncSetAttribute failed\n"); grid = -1; return; }
        if (hipOccupancyMaxActiveBlocksPerMultiprocessor(&per_cu, (const void*)mk_fwd, 512, LDS_BYTES) != hipSuccess || per_cu < 1) { fprintf(stderr, "kernel_launch: occupancy query says %d\n", per_cu); per_cu = 1; }
        (void)hipGetLastError();
        grid = cus;
        fprintf(stderr, "kernel_launch: cus %d per_cu %d grid %d\n", cus, per_cu, grid);
    }
    if (grid < 0) return;
    hipMemsetAsync((char*)d_ws + WS_CTL, 0, CTL_BYTES, stream);
    Args a{};
    for (int i = 0; i < 12; ++i) a.in[i] = (const float*)d_in[i];
    a.out = (float*)d_out; a.ws = (unsigned char*)d_ws;
    for (int i = 0; i < 64; ++i) a.inv.h[i] = (float)std::pow(10000.0, -(double)(2 * i) / 128.0);
    for (int i = 0; i < 32; ++i) a.inv.i[i] = (float)std::pow(10000.0, -(double)(2 * i) / 64.0);
    constexpr int NPH = 1 + 4 * DEPTH;
#if MK_N_LAUNCHES == 1
    a.ph_lo = 0; a.ph_hi = NPH; a.coop = 1;
    void* kargs[] = {&a};
    hipError_t e = hipLaunchCooperativeKernel((const void*)mk_fwd, dim3(grid), dim3(512), kargs, LDS_BYTES, stream);
    if (e != hipSuccess) fprintf(stderr, "kernel_launch: cooperative launch failed: %s (grid %d)\n", hipGetErrorString(e), grid);
#else
    for (int ph = 0; ph < NPH; ++ph) { a.ph_lo = ph; a.ph_hi = ph + 1; a.coop = 0; hipLaunchKernelGGL(mk_fwd, dim3(grid), dim3(512), LDS_BYTES, stream, a); }
#endif
}
```

```cpp
#include <hip/hip_runtime.h>
#include <hip/hip_cooperative_groups.h>
#include <cstdio>
#include <cstdint>
#include <cmath>
namespace cg = cooperative_groups;

#ifndef MK_N_LAUNCHES
#define MK_N_LAUNCHES 1
#endif

#ifndef PROBE_DUP
#define PROBE_DUP 0
#endif
#define LAS __attribute__((address_space(3)))
typedef unsigned short bf16_t;
typedef short bf16x8 __attribute__((ext_vector_type(8)));
typedef short s16x4 __attribute__((ext_vector_type(4)));
typedef float f32x4 __attribute__((ext_vector_type(4)));
typedef float f32x2 __attribute__((ext_vector_type(2)));
typedef float f32x16 __attribute__((ext_vector_type(16)));
typedef unsigned u32x4 __attribute__((ext_vector_type(4)));
typedef unsigned u32x2 __attribute__((ext_vector_type(2)));

constexpr int D_MODEL = 2048, BATCH = 4, SEQ = 2048, DEPTH = 4, CHUNK = 64, HD = 128, DPLE = 256;
constexpr int T = BATCH * SEQ;
constexpr int DIN = 6984;
constexpr int C_QA = 0, C_KA = 1024, C_VA = 2048, C_GA = 3072, C_QB = 4096, C_KB = 5120, C_VB = 5248, C_GB = 5376, C_QI = 6400, C_KI = 6912, C_WI = 6976;
constexpr int NCAT = 9216, WPITCH = D_MODEL + 64, PPITCH = DPLE + 64;
constexpr float ALPHA = 1.681792830507429f;
constexpr float LN_EPS = 1e-5f;
constexpr float SCALE = 0.088388347648318440f;
constexpr float NEGB = -1e30f;

constexpr size_t MiB = 1u << 20;
constexpr size_t WS_CTL = 0, CTL_BYTES = 1 * MiB;
constexpr size_t WS_WCAT = 1 * MiB;
constexpr size_t WS_WOUT = WS_WCAT + 152 * MiB;
constexpr size_t WS_WPLE = WS_WOUT + 34 * MiB;
constexpr size_t WS_PBF = WS_WPLE + 6 * MiB;
constexpr size_t WS_XB = WS_PBF + 16 * MiB;
constexpr size_t WS_XF = WS_XB + 32 * MiB;
constexpr size_t WS_QA = WS_XF + 64 * MiB;
constexpr size_t WS_KA = WS_QA + 16 * MiB, WS_VA = WS_KA + 16 * MiB, WS_SGA = WS_VA + 16 * MiB, WS_QB = WS_SGA + 16 * MiB, WS_SGB = WS_QB + 16 * MiB;
constexpr size_t WS_KB = WS_SGB + 16 * MiB;
constexpr size_t WS_VB = WS_KB + 2 * MiB;
constexpr size_t WS_QI = WS_VB + 2 * MiB;
constexpr size_t WS_KI = WS_QI + 8 * MiB;
constexpr size_t WS_WI = WS_KI + 1 * MiB;
constexpr size_t WS_GATE = WS_WI + 1 * MiB;
constexpr size_t WS_PLE = WS_GATE + 32 * MiB;
constexpr size_t WS_YMIX = WS_PLE + 32 * MiB;
constexpr size_t WS_COSH = WS_YMIX + 32 * MiB;
constexpr size_t WS_SINH = WS_COSH + 2 * MiB;
constexpr size_t WS_COSI = WS_SINH + 2 * MiB;
constexpr size_t WS_SINI = WS_COSI + 1 * MiB;
constexpr size_t WS_END = WS_SINI + 1 * MiB;
constexpr int CW_QUEUE = 64, CW_BAR = 4096;

static_assert((size_t)4 * NCAT * WPITCH * 2 <= 152 * MiB && (size_t)4 * D_MODEL * WPITCH * 2 <= 34 * MiB && (size_t)4 * D_MODEL * PPITCH * 2 <= 6 * MiB, "weight copies fit");
constexpr int RING_BYTES = 131072;
constexpr int L_WAVE = RING_BYTES;
constexpr int L_MASK = L_WAVE + 2048;
constexpr int L_BIAS = L_MASK + 8192;
constexpr int L_XCH = L_BIAS + 1280;
constexpr int L_CTL = L_XCH + 2048;
constexpr int LDS_BYTES = 147456;
static_assert(L_CTL + 64 <= LDS_BYTES, "LDS map");

struct InvTab { float h[64]; float i[32]; };
struct Args { const float* in[12]; float* out; unsigned char* ws; InvTab inv; int ph_lo, ph_hi, coop, pad; };

__device__ __forceinline__ unsigned cvt_pk_bf16(float lo, float hi) { unsigned r; asm volatile("s_nop 1\n\tv_cvt_pk_bf16_f32 %0, %1, %2" : "=v"(r) : "v"(lo), "v"(hi)); return r; }
__device__ __forceinline__ float bf2f(unsigned short b) { return __uint_as_float(((unsigned)b) << 16); }
__device__ __forceinline__ float bflo(unsigned w) { return __uint_as_float(w << 16); }
__device__ __forceinline__ float bfhi(unsigned w) { return __uint_as_float(w & 0xffff0000u); }

namespace pg8 {
constexpr int BM = 256, BK = 64, HALF = 128, HTB = HALF * BK * 2, STAGE_BYTES = 8 * HTB, NXCD = 8, WGM = 8;
__host__ __device__ __forceinline__ int lds_byte(int r, int c) { const int st = (r >> 4) * 2 + (c >> 5), rr = r & 15, cc = c & 31, ob = rr * 64 + cc * 2; return st * 1024 + (ob ^ (((ob >> 9) & 1) << 5)); }
__host__ __device__ __forceinline__ void stage_rc(int b, int& R, int& C) { const int st = b / 1024, sb = b % 1024, swz = sb ^ (((sb >> 9) & 1) << 5); R = (st >> 1) * 16 + swz / 64; C = (st & 1) * 32 + (swz % 64) / 2; }
__host__ __device__ __forceinline__ int perm32(int rho) { const int n = rho >> 4, i = rho & 15; return 8 * (i >> 2) + 4 * n + (i & 3); }
struct Unit { int pm, pn; };
struct Gemm { const bf16_t* A; const bf16_t* Bt; int M, N, K, ldb; };
struct StaticOrder {
    int nM, nN, nwg, G, c;
    __host__ __device__ void init(int M, int N, int G_, int c_) { nM = M / BM; nN = N / BM; nwg = nM * nN; G = G_; c = c_; }
    __host__ __device__ bool next(int i, Unit& u) const {
        const long L = (long)i * G + c; if (L >= nwg) return false;
        int wgid = (int)L; { const int q = nwg / NXCD, r = nwg % NXCD, xcd = wgid % NXCD, off = wgid / NXCD; wgid = (xcd < r ? xcd * (q + 1) : r * (q + 1) + (xcd - r) * q) + off; }
        const int nig = WGM * nN, gid = wgid / nig, fm = gid * WGM, gsz = (nM - fm) < WGM ? (nM - fm) : WGM;
        u.pm = fm + ((wgid % nig) % gsz); u.pn = (wgid % nig) / gsz; return true;
    }
    __device__ __forceinline__ void a_ready(const Unit&) const {}
    __device__ __forceinline__ void done(const Unit&) const {}
};

struct OneUnit {
    Unit u;
    __device__ __forceinline__ bool next(int i, Unit& o) const { if (i) return false; o = u; return true; }
    __device__ __forceinline__ void a_ready(const Unit&) const {}
    __device__ __forceinline__ void done(const Unit&) const {}
};

template <class Epi, class Sched, bool ALIGN_EPI = false, bool SP2 = false>
__device__ __forceinline__ void gemm_phase(LAS unsigned char* lds, const Gemm g, const Sched& S, const Epi& E) {
    int tid_ = threadIdx.x; asm volatile("" : "+v"(tid_));
    const int tid = tid_, wid = __builtin_amdgcn_readfirstlane(tid >> 6), lane = tid & 63, wr = wid >> 2, wc = wid & 3, fr = lane & 15, fq = lane >> 4;
    const int K = g.K, nt = K / BK;
    unsigned voffA[2], voffB[2];
#pragma unroll
    for (int i = 0; i < 2; ++i) { int R, C; stage_rc(tid * 16 + i * 8192, R, C); const int Rb = Epi::PERM ? ((R & ~31) + perm32(R & 31)) : R;
        voffA[i] = (unsigned)(R * K + C) * 2u; voffB[i] = (unsigned)(Rb * g.ldb + C) * 2u; }
    const size_t kstep = (size_t)(BK * 2);
    const size_t hstep = (size_t)HALF * K * 2, hstepB = (size_t)HALF * g.ldb * 2;
    const size_t tstep = 2 * hstep, tstepB = 2 * hstepB;
    const unsigned ldsw = (unsigned)wid * 1024u;
    const int aoff = lds_byte(wr * 64 + fr, fq * 8), boff = lds_byte(wc * 32 + fr, fq * 8);
#define PG8_SA(b, h) (((b) * 2 + (h)) * HTB)
#define PG8_SB(b, h) ((4 + (b) * 2 + (h)) * HTB)
#define PG8_STAGE(bufoff, gbase, voff) do { _Pragma("unroll") for (int _i = 0; _i < 2; ++_i) \
        __builtin_amdgcn_global_load_lds((const unsigned*)((const char*)(gbase) + (voff)[_i]), (LAS unsigned*)(lds + (bufoff) + ldsw + _i * 8192), 16, 0, 0); } while (0)
#define PG8_LDA(dst, b, h) do { _Pragma("unroll") for (int m = 0; m < 4; ++m) _Pragma("unroll") for (int k = 0; k < 2; ++k) dst[m][k] = *(const LAS bf16x8*)(lds + PG8_SA(b, h) + aoff + m * 2048 + k * 1024); } while (0)
#define PG8_LDB(dst, b, h) do { _Pragma("unroll") for (int n = 0; n < 2; ++n) _Pragma("unroll") for (int k = 0; k < 2; ++k) dst[n][k] = *(const LAS bf16x8*)(lds + PG8_SB(b, h) + boff + n * 2048 + k * 1024); } while (0)
#define PG8_MMA(ai, bj, At, Bt) do { __builtin_amdgcn_s_setprio(1); _Pragma("unroll") for (int m = 0; m < 4; ++m) _Pragma("unroll") for (int n = 0; n < 2; ++n) _Pragma("unroll") for (int k = 0; k < 2; ++k) \
        acc[ai][bj][m][n] = __builtin_amdgcn_mfma_f32_16x16x32_bf16(Bt[n][k], At[m][k], acc[ai][bj][m][n], 0, 0, 0); __builtin_amdgcn_s_setprio(0); } while (0)
#define PG8_WAIT_V(n) asm volatile("s_waitcnt vmcnt(" #n ")" ::: "memory")
#define PG8_WAIT_L(n) asm volatile("s_waitcnt lgkmcnt(" #n ")" ::: "memory")
#define PG8_BAR __builtin_amdgcn_s_barrier()
#define PG8_SCHED __builtin_amdgcn_sched_barrier(0)
    Unit cur, nxt; int ui = 0;
    if (!S.next(0, cur)) return;
    f32x4 acc[2][2][4][2];
#pragma unroll
    for (int a = 0; a < 2; ++a)
#pragma unroll
        for (int b = 0; b < 2; ++b)
#pragma unroll
            for (int m = 0; m < 4; ++m)
#pragma unroll
                for (int n = 0; n < 2; ++n) acc[a][b][m][n] = (f32x4){0.f, 0.f, 0.f, 0.f};
    bf16x8 At[4][2], B0[2][2], B1[2][2];
    const char* cA = (const char*)g.A + (size_t)cur.pm * tstep; const char* cB = (const char*)g.Bt + (size_t)cur.pn * tstepB;
    S.a_ready(cur);
    if constexpr (SP2) {
        PG8_STAGE(PG8_SB(0, 0), cB, voffB); PG8_STAGE(PG8_SB(0, 1), cB + hstepB, voffB); PG8_STAGE(PG8_SA(0, 0), cA, voffA); PG8_STAGE(PG8_SA(0, 1), cA + hstep, voffA);
        if (wr == 1) PG8_BAR;
        PG8_WAIT_V(2); PG8_BAR;
        PG8_STAGE(PG8_SB(1, 0), cB + kstep, voffB); PG8_STAGE(PG8_SA(1, 0), cA + kstep, voffA); PG8_STAGE(PG8_SB(1, 1), cB + hstepB + kstep, voffB);
        PG8_WAIT_V(6); PG8_BAR;
    } else {
        PG8_STAGE(PG8_SB(0, 0), cB, voffB); PG8_STAGE(PG8_SA(0, 0), cA, voffA); PG8_STAGE(PG8_SB(0, 1), cB + hstepB, voffB); PG8_STAGE(PG8_SA(0, 1), cA + hstep, voffA);
        if (wr == 1) PG8_BAR;
        PG8_WAIT_V(4); PG8_BAR;
        PG8_STAGE(PG8_SB(1, 0), cB + kstep, voffB); PG8_STAGE(PG8_SA(1, 0), cA + kstep, voffA); PG8_STAGE(PG8_SB(1, 1), cB + hstepB + kstep, voffB);
        PG8_WAIT_V(6); PG8_BAR;
    }
    for (;;) {
        const bool has_next = S.next(ui + 1, nxt);
        const char* nA = has_next ? (const char*)g.A + (size_t)nxt.pm * tstep : cA; const char* nB = has_next ? (const char*)g.Bt + (size_t)nxt.pn * tstepB : cB;
        for (int t = 0; t < nt; t += 2) {
            const bool last = (t == nt - 2);
            const char* a1 = cA + (size_t)(t + 1) * kstep;
            const char* a2 = last ? nA : cA + (size_t)(t + 2) * kstep; const char* b2 = last ? nB : cB + (size_t)(t + 2) * kstep;
            const char* a3 = a2 + kstep; const char* b3 = b2 + kstep;
            if (last && has_next) S.a_ready(nxt);
            if constexpr (SP2) {
            PG8_LDB(B0, 0, 0); PG8_LDB(B1, 0, 1); PG8_SCHED; PG8_LDA(At, 0, 0); PG8_STAGE(PG8_SA(1, 1), a1 + hstep, voffA);
            PG8_WAIT_V(8); PG8_WAIT_L(0); PG8_BAR; PG8_MMA(0, 0, At, B0); PG8_MMA(0, 1, At, B1); PG8_BAR; PG8_SCHED;
            PG8_LDA(At, 0, 1); PG8_STAGE(PG8_SB(0, 0), b2, voffB); PG8_STAGE(PG8_SB(0, 1), b2 + hstepB, voffB); PG8_STAGE(PG8_SA(0, 0), a2, voffA);
            PG8_WAIT_V(8); PG8_WAIT_L(0); PG8_BAR; PG8_MMA(1, 0, At, B0); PG8_MMA(1, 1, At, B1); PG8_BAR; PG8_SCHED;
            PG8_LDB(B0, 1, 0); PG8_LDB(B1, 1, 1); PG8_SCHED; PG8_LDA(At, 1, 0); PG8_STAGE(PG8_SA(0, 1), a2 + hstep, voffA);
            PG8_WAIT_V(8); PG8_WAIT_L(0); PG8_BAR; PG8_MMA(0, 0, At, B0); PG8_MMA(0, 1, At, B1); PG8_BAR; PG8_SCHED;
            PG8_LDA(At, 1, 1); PG8_STAGE(PG8_SB(1, 0), b3, voffB); PG8_STAGE(PG8_SB(1, 1), b3 + hstepB, voffB); PG8_STAGE(PG8_SA(1, 0), a3, voffA);
            PG8_WAIT_V(8); PG8_WAIT_L(0); PG8_BAR; PG8_MMA(1, 0, At, B0); PG8_MMA(1, 1, At, B1); PG8_BAR; PG8_SCHED;
            } else {
            PG8_LDB(B0, 0, 0); PG8_SCHED; PG8_LDA(At, 0, 0); PG8_STAGE(PG8_SA(1, 1), a1 + hstep, voffA);
            PG8_WAIT_L(8); PG8_BAR; PG8_WAIT_L(0); PG8_MMA(0, 0, At, B0); PG8_BAR; PG8_SCHED;
            PG8_LDB(B1, 0, 1); PG8_STAGE(PG8_SB(0, 0), b2, voffB);
            PG8_BAR; PG8_WAIT_L(0); PG8_MMA(0, 1, At, B1); PG8_BAR;
            PG8_LDA(At, 0, 1); PG8_STAGE(PG8_SA(0, 0), a2, voffA);
            PG8_BAR; PG8_WAIT_L(0); PG8_MMA(1, 0, At, B0); PG8_BAR; PG8_SCHED;
            PG8_STAGE(PG8_SB(0, 1), b2 + hstepB, voffB);
            PG8_WAIT_V(6); PG8_BAR; PG8_MMA(1, 1, At, B1); PG8_BAR;
            PG8_LDB(B0, 1, 0); PG8_SCHED; PG8_LDA(At, 1, 0); PG8_STAGE(PG8_SA(0, 1), a2 + hstep, voffA);
            PG8_WAIT_L(8); PG8_BAR; PG8_WAIT_L(0); PG8_MMA(0, 0, At, B0); PG8_BAR; PG8_SCHED;
            PG8_LDB(B1, 1, 1); PG8_STAGE(PG8_SB(1, 0), b3, voffB);
            PG8_BAR; PG8_WAIT_L(0); PG8_MMA(0, 1, At, B1); PG8_BAR;
            PG8_LDA(At, 1, 1); PG8_STAGE(PG8_SA(1, 0), a3, voffA);
            PG8_BAR; PG8_WAIT_L(0); PG8_MMA(1, 0, At, B0); PG8_BAR; PG8_SCHED;
            PG8_STAGE(PG8_SB(1, 1), b3 + hstepB, voffB);
            PG8_WAIT_V(6); PG8_BAR; PG8_MMA(1, 1, At, B1); PG8_BAR;
            }
        }
        if constexpr (ALIGN_EPI) { if (wr == 0) PG8_BAR; }
        E(acc, cur, wr, wc, fr, fq); if constexpr (Epi::IDEM) { if (PROBE_DUP == 13) E(acc, cur, wr, wc, fr, fq); } S.done(cur);
        if (!has_next) break;
#pragma unroll
        for (int a = 0; a < 2; ++a)
#pragma unroll
            for (int b = 0; b < 2; ++b)
#pragma unroll
                for (int m = 0; m < 4; ++m)
#pragma unroll
                    for (int n = 0; n < 2; ++n) acc[a][b][m][n] = (f32x4){0.f, 0.f, 0.f, 0.f};
        cur = nxt; cA = nA; cB = nB; ++ui;
        if constexpr (ALIGN_EPI) { if (wr == 1) PG8_BAR; }
    }
    PG8_WAIT_V(0);
    if constexpr (!ALIGN_EPI) { if (wr == 0) PG8_BAR; }
    PG8_BAR;
#undef PG8_SA
#undef PG8_SB
#undef PG8_STAGE
#undef PG8_LDA
#undef PG8_LDB
#undef PG8_MMA
#undef PG8_WAIT_V
#undef PG8_WAIT_L
#undef PG8_BAR
#undef PG8_SCHED
}
}

__device__ __forceinline__ float sigm_f(float g) { return __builtin_amdgcn_rcpf(1.f + __builtin_amdgcn_exp2f(g * -1.4426950408889634f)); }
__device__ __forceinline__ float silu_f(float g) { return g * sigm_f(g); }
__device__ __forceinline__ f32x4 ld4(const float* p) { return *(const f32x4*)p; }
__device__ __forceinline__ void st_bf8(bf16_t* p, f32x4 a, f32x4 b) { u32x4 w; w.x = cvt_pk_bf16(a[0], a[1]); w.y = cvt_pk_bf16(a[2], a[3]); w.z = cvt_pk_bf16(b[0], b[1]); w.w = cvt_pk_bf16(b[2], b[3]); *(u32x4*)p = w; }
__device__ __forceinline__ void st_bf4(bf16_t* p, f32x4 a) { u32x2 w; w.x = cvt_pk_bf16(a[0], a[1]); w.y = cvt_pk_bf16(a[2], a[3]); *(u32x2*)p = w; }

#ifndef ROPE_RB
#define ROPE_RB 8
#endif
struct EpiProj {
    static constexpr bool PERM = true, IDEM = true;
    unsigned char* wsb; const float *b_in, *b_pg;
    template <int ACT> __device__ __forceinline__ void plain(const f32x4 (&acc)[2][2][4][2], int bj, int row0, bf16_t* dst, int ldc, int col, f32x4 b0, f32x4 b1) const {
#pragma unroll
        for (int ai = 0; ai < 2; ++ai)
#pragma unroll
            for (int m = 0; m < 4; ++m) {
                f32x4 v0 = acc[ai][bj][m][0] + b0, v1 = acc[ai][bj][m][1] + b1;
                if (ACT == 1) {
#pragma unroll
                    for (int j = 0; j < 4; ++j) { v0[j] = silu_f(v0[j]); v1[j] = silu_f(v1[j]); } }
                if (ACT == 2) {
#pragma unroll
                    for (int j = 0; j < 4; ++j) { v0[j] = sigm_f(v0[j]); v1[j] = sigm_f(v1[j]); } }
                st_bf8(dst + ((unsigned)(row0 + ai * 128 + m * 16) * (unsigned)ldc + col), v0, v1);
            }
    }
    template <int ACT> __device__ __forceinline__ void plain2(const f32x4 (&acc)[2][2][4][2], int row0, bf16_t* dst, int ldc, int col0, const float* bias) const {
        const f32x4 b00 = ld4(bias), b01 = ld4(bias + 4), b10 = ld4(bias + 128), b11 = ld4(bias + 132);
        plain<ACT>(acc, 0, row0, dst, ldc, col0, b00, b01); plain<ACT>(acc, 1, row0, dst, ldc, col0 + 128, b10, b11);
    }
    template <int HALFD> __device__ __forceinline__ void rope(const f32x4 (&acc)[2][2][4][2], int bj, int row0, bf16_t* dst, int ldc, int hcol, int d1, f32x4 b0, f32x4 b1, const float* ct, const float* st) const {
#pragma unroll
        for (int ai = 0; ai < 2; ++ai) {
            f32x4 c[4], s[4];
#pragma unroll
            for (int m = 0; m < 4; ++m) { const unsigned r = (unsigned)(row0 + ai * 128 + m * 16); c[m] = ld4(ct + (r * HALFD + d1)); s[m] = ld4(st + (r * HALFD + d1)); }
#pragma unroll
            for (int m = 0; m < 4; ++m) {
                const int r = row0 + ai * 128 + m * 16;
                const f32x4 t1 = acc[ai][bj][m][0] + b0, t2 = acc[ai][bj][m][1] + b1;
                const f32x4 o1 = t1 * c[m] - t2 * s[m], o2 = t2 * c[m] + t1 * s[m];
                st_bf4(dst + ((unsigned)r * (unsigned)ldc + hcol + d1), o1); st_bf4(dst + ((unsigned)r * (unsigned)ldc + hcol + HALFD + d1), o2);
            }
        }
    }
    template <int HALFD, int RB> __device__ __forceinline__ void rope2(const f32x4 (&acc)[2][2][4][2], int row0, bf16_t* dst, int ldc, int hcol0, int hcol1, int d1, f32x4 b00, f32x4 b01, f32x4 b10, f32x4 b11, const float* ct, const float* st) const {
#pragma unroll
        for (int g = 0; g < 8 / RB; ++g) {
            f32x4 c[RB], s[RB];
#pragma unroll
            for (int i = 0; i < RB; ++i) { const int q = g * RB + i; const unsigned r = (unsigned)(row0 + (q >> 2) * 128 + (q & 3) * 16); c[i] = ld4(ct + (r * HALFD + d1)); s[i] = ld4(st + (r * HALFD + d1)); }
#pragma unroll
            for (int i = 0; i < RB; ++i) { const int q = g * RB + i, ai = q >> 2, m = q & 3; const unsigned r = (unsigned)(row0 + ai * 128 + m * 16);
                { const f32x4 t1 = acc[ai][0][m][0] + b00, t2 = acc[ai][0][m][1] + b01; st_bf4(dst + (r * (unsigned)ldc + hcol0 + d1), t1 * c[i] - t2 * s[i]); st_bf4(dst + (r * (unsigned)ldc + hcol0 + HALFD + d1), t2 * c[i] + t1 * s[i]); }
                { const f32x4 t1 = acc[ai][1][m][0] + b10, t2 = acc[ai][1][m][1] + b11; st_bf4(dst + (r * (unsigned)ldc + hcol1 + d1), t1 * c[i] - t2 * s[i]); st_bf4(dst + (r * (unsigned)ldc + hcol1 + HALFD + d1), t2 * c[i] + t1 * s[i]); } }
        }
    }
    __device__ __forceinline__ void operator()(const f32x4 (&acc)[2][2][4][2], const pg8::Unit& u, int wr, int wc, int fr, int fq) const {
        asm volatile("" : "+v"(fr), "+v"(fq));
        const int pn = u.pn, row0 = u.pm * 256 + wr * 64 + fr, lc = 32 * wc + 8 * fq;
        size_t w_z = 0; asm volatile("" : "+s"(w_z)); unsigned char* w = wsb + w_z;
        bf16_t* const QA = (bf16_t*)(w + WS_QA); bf16_t* const KA = (bf16_t*)(w + WS_KA); bf16_t* const VA = (bf16_t*)(w + WS_VA); bf16_t* const SGA = (bf16_t*)(w + WS_SGA);
        bf16_t* const QB = (bf16_t*)(w + WS_QB); bf16_t* const SGB = (bf16_t*)(w + WS_SGB); bf16_t* const KB = (bf16_t*)(w + WS_KB); bf16_t* const VB = (bf16_t*)(w + WS_VB);
        bf16_t* const QI = (bf16_t*)(w + WS_QI); bf16_t* const KI = (bf16_t*)(w + WS_KI); float* const WI = (float*)(w + WS_WI); bf16_t* const GATE = (bf16_t*)(w + WS_GATE);
        const float* const cosH = (const float*)(w + WS_COSH); const float* const sinH = (const float*)(w + WS_SINH); const float* const cosI = (const float*)(w + WS_COSI); const float* const sinI = (const float*)(w + WS_SINI);
        if (pn < 16) {
            const int seg = pn >> 2; bf16_t* dst = seg == 0 ? QA : seg == 1 ? KA : seg == 2 ? VA : SGA; const int col = (pn & 3) * 256 + lc;
            if (seg == 3) plain2<1>(acc, row0, dst, 1024, col, b_in + seg * 1024 + col); else plain2<0>(acc, row0, dst, 1024, col, b_in + seg * 1024 + col);
        } else if (pn < 20) {
            const int h0 = (pn - 16) * 2, d1 = 4 * (4 * wc + fq); const float* bb = b_in + C_QB + h0 * 128 + d1;
            const f32x4 b00 = ld4(bb), b01 = ld4(bb + 64), b10 = ld4(bb + 128), b11 = ld4(bb + 192);
            rope2<64, ROPE_RB>(acc, row0, QB, 1024, h0 * 128, (h0 + 1) * 128, d1, b00, b01, b10, b11, cosH, sinH);
        } else if (pn < 24) {
            const int col = (pn - 20) * 256 + lc; plain2<1>(acc, row0, SGB, 1024, col, b_in + C_GB + col);
        } else if (pn == 24) {
            const int d1 = 4 * (4 * wc + fq);
            const f32x4 b00 = ld4(b_in + C_KB + d1), b01 = ld4(b_in + C_KB + 64 + d1), b10 = ld4(b_in + C_VB + lc), b11 = ld4(b_in + C_VB + lc + 4);
            rope<64>(acc, 0, row0, KB, 128, 0, d1, b00, b01, cosH, sinH);
            plain<0>(acc, 1, row0, VB, 128, lc, b10, b11);
        } else if (pn < 27) {
            const int h0 = (pn - 25) * 4 + (wc >> 1), d1 = 4 * ((4 * wc + fq) & 7); const float* bb = b_in + C_QI + h0 * 64 + d1;
            const f32x4 b00 = ld4(bb), b01 = ld4(bb + 32), b10 = ld4(bb + 128), b11 = ld4(bb + 160);
            rope2<32, ROPE_RB>(acc, row0, QI, 512, h0 * 64, (h0 + 2) * 64, d1, b00, b01, b10, b11, cosI, sinI);
        } else if (pn == 27) {
            if (wc < 2) { const int d1 = 4 * (4 * wc + fq); const f32x4 b00 = ld4(b_in + C_KI + d1), b01 = ld4(b_in + C_KI + 32 + d1); rope<32>(acc, 0, row0, KI, 64, 0, d1, b00, b01, cosI, sinI); }
            else if (wc == 2 && fq == 0) {
                const f32x4 b0 = ld4(b_in + C_WI), b1 = ld4(b_in + C_WI + 4); const float sc = 0.35355339059327373f * 0.125f;
#pragma unroll
                for (int ai = 0; ai < 2; ++ai)
#pragma unroll
                    for (int m = 0; m < 4; ++m) { float* p = WI + (size_t)(row0 + ai * 128 + m * 16) * 8; *(f32x4*)p = (acc[ai][0][m][0] + b0) * sc; *(f32x4*)(p + 4) = (acc[ai][0][m][1] + b1) * sc; }
            }
        } else {
            const int col = (pn - 28) * 256 + lc; plain2<2>(acc, row0, GATE, 2048, col, b_pg + col);
        }
    }
};
struct EpiPlain {
    static constexpr bool PERM = true, IDEM = false;
    bf16_t* O; int ldc;
    __device__ __forceinline__ void operator()(const f32x4 (&acc)[2][2][4][2], const pg8::Unit& u, int wr, int wc, int fr, int fq) const {
        asm volatile("" : "+v"(fr), "+v"(fq));
        const int row0 = u.pm * 256 + wr * 64 + fr;
#pragma unroll
        for (int bj = 0; bj < 2; ++bj) { const int col = u.pn * 256 + 128 * bj + 32 * wc + 8 * fq;
#pragma unroll
            for (int ai = 0; ai < 2; ++ai)
#pragma unroll
                for (int m = 0; m < 4; ++m) st_bf8(O + (size_t)(row0 + ai * 128 + m * 16) * ldc + col, acc[ai][bj][m][0], acc[ai][bj][m][1]); }
    }
};
struct EpiRes {
    static constexpr bool PERM = true, IDEM = false;
    const float* xres; unsigned char* wsb;
    __device__ __forceinline__ void operator()(const f32x4 (&acc)[2][2][4][2], const pg8::Unit& u, int wr, int wc, int fr, int fq) const {
        asm volatile("" : "+v"(fr), "+v"(fq));
        const int row0 = u.pm * 256 + wr * 64 + fr;
        size_t w_z = 0; asm volatile("" : "+s"(w_z)); unsigned char* w = wsb + w_z;
        float* const XF = (float*)(w + WS_XF); const bf16_t* const GATE = (const bf16_t*)(w + WS_GATE); const bf16_t* const PLE = (const bf16_t*)(w + WS_PLE);
#pragma unroll
        for (int ai = 0; ai < 2; ++ai)
#pragma unroll
            for (int m = 0; m < 4; ++m)
#pragma unroll
                for (int bj = 0; bj < 2; ++bj) {
                    const size_t off = (size_t)(row0 + ai * 128 + m * 16) * D_MODEL + u.pn * 256 + 128 * bj + 32 * wc + 8 * fq;
                    const f32x4 x0 = ld4(xres + off), x1 = ld4(xres + off + 4); const u32x4 gw = *(const u32x4*)(GATE + off), pw = *(const u32x4*)(PLE + off);
                    f32x4 h0, h1;
                    h0[0] = bflo(gw.x) * bflo(pw.x); h0[1] = bfhi(gw.x) * bfhi(pw.x); h0[2] = bflo(gw.y) * bflo(pw.y); h0[3] = bfhi(gw.y) * bfhi(pw.y);
                    h1[0] = bflo(gw.z) * bflo(pw.z); h1[1] = bfhi(gw.z) * bfhi(pw.z); h1[2] = bflo(gw.w) * bflo(pw.w); h1[3] = bfhi(gw.w) * bfhi(pw.w);
                    h0 = h0 + acc[ai][bj][m][0] + x0 * ALPHA; h1 = h1 + acc[ai][bj][m][1] + x1 * ALPHA;
                    *(f32x4*)(XF + off) = h0; *(f32x4*)(XF + off + 4) = h1;
                }
    }
};

#define KSWZ(row, colB) ((row) * 256 + ((colB) ^ (((row) & 7) << 4)))
#define SBAR() __builtin_amdgcn_sched_barrier(0)
__device__ __forceinline__ int crow(int r, int hi) { return (r & 3) + 8 * (r >> 2) + 4 * hi; }
constexpr float ATHR = 8.f;
__device__ __forceinline__ void partialSM(f32x16& p0, f32x16& p1, float& m_reg, float& mn, float& alpha) {
    constexpr float C = SCALE * 1.4426950408889634f;
    float pmax = p0[0];
#pragma unroll
    for (int r = 1; r < 16; ++r) pmax = fmaxf(pmax, p0[r]);
#pragma unroll
    for (int r = 0; r < 16; ++r) pmax = fmaxf(pmax, p1[r]);
    { auto rr = __builtin_amdgcn_permlane32_swap(__float_as_uint(pmax), __float_as_uint(pmax), false, false); pmax = fmaxf(__uint_as_float(rr[0]), __uint_as_float(rr[1])); }
    if (__builtin_expect(__all(pmax - m_reg <= ATHR / SCALE), 1)) { mn = m_reg; alpha = 1.f; }
    else { mn = fmaxf(m_reg, pmax); alpha = __builtin_amdgcn_exp2f((m_reg - mn) * C); m_reg = mn; }
    const float mnC = -mn * C;
#pragma unroll
    for (int r = 0; r < 16; ++r) p0[r] = fmaf(p0[r], C, mnC);
#pragma unroll
    for (int r = 0; r < 16; ++r) p1[r] = fmaf(p1[r], C, mnC);
#pragma unroll
    for (int r = 0; r < 16; ++r) p0[r] = __builtin_amdgcn_exp2f(p0[r]);
}
__device__ __forceinline__ void finishSM(f32x16& p0, f32x16& p1, float alpha, float& l_reg, bf16x8& pa0, bf16x8& pa1, bf16x8& pa2, bf16x8& pa3) {
#pragma unroll
    for (int r = 0; r < 16; ++r) p1[r] = __builtin_amdgcn_exp2f(p1[r]);
    float ps = 0;
#pragma unroll
    for (int r = 0; r < 16; ++r) ps += p0[r];
#pragma unroll
    for (int r = 0; r < 16; ++r) ps += p1[r];
    { auto rr = __builtin_amdgcn_permlane32_swap(__float_as_uint(ps), __float_as_uint(ps), false, false); ps = __uint_as_float(rr[0]) + __uint_as_float(rr[1]); }
    l_reg = l_reg * alpha + ps;
#define PK4(P, BASE, OUT) do { unsigned a0 = cvt_pk_bf16(P[BASE + 0], P[BASE + 1]), a1 = cvt_pk_bf16(P[BASE + 2], P[BASE + 3]);   \
    unsigned b0 = cvt_pk_bf16(P[BASE + 4], P[BASE + 5]), b1 = cvt_pk_bf16(P[BASE + 6], P[BASE + 7]);                              \
    auto r0 = __builtin_amdgcn_permlane32_swap(a0, b0, false, false); auto r1 = __builtin_amdgcn_permlane32_swap(a1, b1, false, false); \
    u32x4 w = {r0[0], r1[0], r0[1], r1[1]}; OUT = *reinterpret_cast<bf16x8*>(&w); } while (0)
    PK4(p0, 0, pa0); PK4(p0, 8, pa1); PK4(p1, 0, pa2); PK4(p1, 8, pa3);
#undef PK4
}
__device__ __forceinline__ void qkt(f32x16& p0, f32x16& p1, const LAS unsigned char* Ks, const bf16x8* qr, int r32, int hi, float init) {
#pragma unroll
    for (int r = 0; r < 16; ++r) { p0[r] = init; p1[r] = init; }
#pragma unroll
    for (int d0 = 0; d0 < 8; ++d0) { const int cb = (d0 * 16 + hi * 8) * 2;
        const bf16x8 b0 = *(const LAS bf16x8*)(Ks + KSWZ(r32, cb));
        const bf16x8 b1 = *(const LAS bf16x8*)(Ks + KSWZ(32 + r32, cb));
        p0 = __builtin_amdgcn_mfma_f32_32x32x16_bf16(b0, qr[d0], p0, 0, 0, 0);
        p1 = __builtin_amdgcn_mfma_f32_32x32x16_bf16(b1, qr[d0], p1, 0, 0, 0); }
}
__device__ __forceinline__ int v_st(int k, int c) { const int kk = (k & ~0xC) | ((k & 4) << 1) | ((k & 8) >> 1); return ((kk >> 3) * 4 + (c >> 5)) * 512 + ((kk & 7) * 32 + (c & 31)) * 2; }
__device__ __forceinline__ int v_rd_base(int lane) { return ((lane & 3) << 3) | (((lane >> 2) & 3) << 6) | (((lane >> 4) & 1) << 5) | (((lane >> 5) & 1) << 8); }
constexpr int v_rd_off(int d0, int ks, int half) { return d0 * 512 + ks * 4096 + half * 2048; }
template <int OFF> __device__ __forceinline__ s16x4 tr_read(int vb) { s16x4 r; asm volatile("ds_read_b64_tr_b16 %0, %1 offset:%2" : "=&v"(r) : "v"(vb), "i"(OFF) : "memory"); return r; }
template <int D0> __device__ __forceinline__ void pv_one(f32x16& od, int vb, bf16x8 pa0, bf16x8 pa1, bf16x8 pa2, bf16x8 pa3) {
    const s16x4 l0 = tr_read<v_rd_off(D0, 0, 0)>(vb), h0 = tr_read<v_rd_off(D0, 0, 1)>(vb), l1 = tr_read<v_rd_off(D0, 1, 0)>(vb), h1 = tr_read<v_rd_off(D0, 1, 1)>(vb);
    const s16x4 l2 = tr_read<v_rd_off(D0, 2, 0)>(vb), h2 = tr_read<v_rd_off(D0, 2, 1)>(vb), l3 = tr_read<v_rd_off(D0, 3, 0)>(vb), h3 = tr_read<v_rd_off(D0, 3, 1)>(vb);
    asm volatile("s_waitcnt lgkmcnt(0)" ::: "memory"); SBAR();
#define PKV(L, H) (bf16x8){L[0], L[1], L[2], L[3], H[0], H[1], H[2], H[3]}
    od = __builtin_amdgcn_mfma_f32_32x32x16_bf16(pa0, PKV(l0, h0), od, 0, 0, 0);
    od = __builtin_amdgcn_mfma_f32_32x32x16_bf16(pa1, PKV(l1, h1), od, 0, 0, 0);
    od = __builtin_amdgcn_mfma_f32_32x32x16_bf16(pa2, PKV(l2, h2), od, 0, 0, 0);
    od = __builtin_amdgcn_mfma_f32_32x32x16_bf16(pa3, PKV(l3, h3), od, 0, 0, 0);
#undef PKV
}
__device__ __forceinline__ void pv_d0(f32x16* o, int vb, bf16x8 pa0, bf16x8 pa1, bf16x8 pa2, bf16x8 pa3) {
    pv_one<0>(o[0], vb, pa0, pa1, pa2, pa3); pv_one<1>(o[1], vb, pa0, pa1, pa2, pa3); pv_one<2>(o[2], vb, pa0, pa1, pa2, pa3); pv_one<3>(o[3], vb, pa0, pa1, pa2, pa3);
}

__device__ __forceinline__ void dma_offsets(int wid, int lane, int ldk, unsigned (&ko)[2], unsigned (&vo)[2]) {
#pragma unroll
    for (int r = 0; r < 2; ++r) {
        const int G = r * 512 + wid * 64 + lane;
        const int row = G >> 4, slot = G & 15; ko[r] = (unsigned)(row * ldk + ((slot ^ (row & 7)) * 8)) * 2u;
        const int st = G >> 5, w_ = G & 31, kk = (st >> 2) * 8 + (w_ >> 2), c = (st & 3) * 32 + (w_ & 3) * 8, k = (kk & ~0xC) | ((kk & 4) << 1) | ((kk & 8) >> 1);
        vo[r] = (unsigned)(k * ldk + c) * 2u;
    }
}
#define ADMA(slot_, Kt, Vt) do { _Pragma("unroll") for (int _r = 0; _r < 2; ++_r) { \
        __builtin_amdgcn_global_load_lds((const unsigned*)((const char*)(Kt) + ko[_r]), (LAS unsigned*)(lds + (slot_) * 32768 + _r * 8192 + wid * 1024), 16, 0, 0); \
        __builtin_amdgcn_global_load_lds((const unsigned*)((const char*)(Vt) + vo[_r]), (LAS unsigned*)(lds + (slot_) * 32768 + 16384 + _r * 8192 + wid * 1024), 16, 0, 0); } } while (0)
#define RESC(a) do { if (__any((a) < 1.f)) { if (hi == 0) al_l[r32] = (a); asm volatile("s_waitcnt lgkmcnt(0)" ::: "memory"); \
    _Pragma("unroll") for (int d = 0; d < 4; ++d) _Pragma("unroll") for (int r = 0; r < 16; ++r) o[d][r] *= al_l[crow(r, hi)]; } } while (0)

__device__ __forceinline__ unsigned f2key(float f) { f = f + 0.0f; const unsigned u = __float_as_uint(f); return (u & 0x80000000u) ? ~u : (u | 0x80000000u); }
__device__ __forceinline__ unsigned wave_sum_u32(unsigned x) {
    x += (unsigned)__builtin_amdgcn_update_dpp(0, (int)x, 0xB1, 0xF, 0xF, true);
    x += (unsigned)__builtin_amdgcn_update_dpp(0, (int)x, 0x4E, 0xF, 0xF, true);
    x += (unsigned)__builtin_amdgcn_update_dpp(0, (int)x, 0x141, 0xF, 0xF, true);
    x += (unsigned)__builtin_amdgcn_update_dpp(0, (int)x, 0x140, 0xF, 0xF, true);
    return (unsigned)__builtin_amdgcn_readlane((int)x, 0) + (unsigned)__builtin_amdgcn_readlane((int)x, 16) + (unsigned)__builtin_amdgcn_readlane((int)x, 32) + (unsigned)__builtin_amdgcn_readlane((int)x, 48);
}
template <int NR> __device__ __forceinline__ void sel_write(const unsigned (&u)[NR], unsigned p, int n, LAS unsigned long long* M, int lane) {
    if (n == 256) {
#pragma unroll
        for (int i = 0; i < NR; ++i) { const unsigned long long m = __ballot(u[i] >= p); if (lane == 0) M[i] = m; }
    } else {
        int cgt = 0;
#pragma unroll
        for (int i = 0; i < NR; ++i) cgt += __popcll(__ballot(u[i] > p));
        int need = 256 - cgt;
#pragma unroll
        for (int i = 0; i < NR; ++i) {
            const unsigned long long mg = __ballot(u[i] > p); unsigned long long me = __ballot(u[i] == p);
            int ne = __popcll(me);
            while (ne > need) { me &= ~(1ull << (63 - __clzll((long long)me))); --ne; }
            need -= ne;
            if (lane == 0) M[i] = mg | me;
        }
    }
}
template <int NR> __device__ __forceinline__ void select2(const LAS float* SC, LAS unsigned long long* MASK, int q0, int m0, int lane, int ntile) {
    unsigned uA[NR], uB[NR];
#pragma unroll
    for (int i = 0; i < NR; ++i) { uA[i] = (i < ntile) ? f2key(SC[q0 * 2048 + 64 * i + lane]) : 0u; uB[i] = (i < ntile) ? f2key(SC[(q0 + 1) * 2048 + 64 * i + lane]) : 0u; }
    unsigned pA = 0, pB = 0; int nA = 1 << 20, nB = 1 << 20;
    for (int bit = 31; bit >= 0; --bit) {
        const unsigned cA = pA | (1u << bit), cB = pB | (1u << bit);
        unsigned c0 = 0, c1 = 0;
#pragma unroll
        for (int i = 0; i < NR; ++i) { c0 += (uA[i] >= cA) ? 1u : 0u; c1 += (uB[i] >= cB) ? 1u : 0u; }
        const unsigned c = wave_sum_u32(c0 | (c1 << 16));
        const int tA = (int)(c & 0xffffu), tB = (int)(c >> 16);
        if (tA >= 256) { pA = cA; nA = tA; }
        if (tB >= 256) { pB = cB; nB = tB; }
        if (nA == 256 && nB == 256) break;
    }
    sel_write<NR>(uA, pA, nA, MASK + m0 * 32, lane);
    sel_write<NR>(uB, pB, nB, MASK + (m0 + 1) * 32, lane);
}

template <int MODE> __device__ __forceinline__ void attn_unit(LAS unsigned char* lds, int b, int ia  , int ib  , unsigned char* w, const float* rel_bias) {
    int tid_ = threadIdx.x; asm volatile("" : "+v"(tid_));
    const int tid = tid_, wid = __builtin_amdgcn_readfirstlane(tid >> 6), lane = tid & 63, r32 = lane & 31, hi = lane >> 5;
    LAS float* al_l = (LAS float*)(lds + L_WAVE) + wid * 64; LAS float* li_l = al_l + 32;
    const size_t tokb = (size_t)b * SEQ;
    bf16_t* const YMIX = (bf16_t*)(w + WS_YMIX);
    int nsteps, kc0 = 0, cw = 0, qo = 0, ntile = 0, ldk;
    const bf16_t *Kg, *Vg, *Qw, *SG; size_t tok0; float cfar = 0.f;
    LAS float* tblx = (LAS float*)(lds + L_BIAS);
    LAS unsigned long long* MASK = (LAS unsigned long long*)(lds + L_MASK);
    if (MODE == 0) {
        const int h = ia, n0 = ib * 4; kc0 = n0 >= 8 ? n0 - 8 : 0; nsteps = n0 + 4 - kc0; cw = n0 + (wid >> 1); qo = 32 * (wid & 1) + r32; ldk = 1024;
        const float* rb = rel_bias + h * 257;
        for (int i = tid; i < 320; i += 512) tblx[i] = rb[i < 256 ? i : 256] * (1.f / SCALE);
        cfar = rb[256] * (1.f / SCALE);
        tok0 = tokb + n0 * 64 + 32 * wid;
        Qw = (const bf16_t*)(w + WS_QA) + (tok0 + r32) * 1024 + h * 128 + hi * 8;
        Kg = (const bf16_t*)(w + WS_KA) + (tokb + kc0 * 64) * 1024 + h * 128; Vg = (const bf16_t*)(w + WS_VA) + (tokb + kc0 * 64) * 1024 + h * 128;
        SG = (const bf16_t*)(w + WS_SGA) + h * 128;
    } else {
        const int t0 = ia * 32, c = t0 >> 6, V = 64 * (c + 1); ntile = c + 1; nsteps = ntile; ldk = 128;
        const bf16_t* const QI = (const bf16_t*)(w + WS_QI); const bf16_t* const KI = (const bf16_t*)(w + WS_KI); const float* const WI = (const float*)(w + WS_WI);
        LAS float* SC = (LAS float*)lds;
        for (int half = 0; half < 2; ++half) {
            const size_t tq0 = tokb + t0 + 16 * half;
            {
                bf16x8 af[4][4]; float wv[4][16];
                { const int rho = r32, b2 = (rho >> 2) & 1, b3 = (rho >> 3) & 1, b4 = (rho >> 4) & 1, tq = 2 * b2 + b4, hh = (rho & 3) + 4 * b3;
#pragma unroll
                  for (int g = 0; g < 4; ++g) { const bf16_t* qp = QI + (tq0 + 4 * g + tq) * 512 + hh * 64 + 8 * hi;
#pragma unroll
                      for (int kk = 0; kk < 4; ++kk) af[g][kk] = *(const bf16x8*)(qp + 16 * kk); } }
#pragma unroll
                for (int g = 0; g < 4; ++g)
#pragma unroll
                    for (int r = 0; r < 16; ++r) wv[g][r] = WI[(tq0 + 4 * g + 2 * hi + (r >> 3)) * 8 + (r & 7)];
                const int n32 = V / 32;
                bf16x8 bcur[4], bnxt[4];
                if (wid < n32) { const bf16_t* kq = KI + (tokb + 32 * wid + r32) * 64 + 8 * hi;
#pragma unroll
                    for (int kk = 0; kk < 4; ++kk) bcur[kk] = *(const bf16x8*)(kq + 16 * kk); }
                for (int jt = wid; jt < n32; jt += 8) {
                    if (jt + 8 < n32) { const bf16_t* kq = KI + (tokb + 32 * (jt + 8) + r32) * 64 + 8 * hi;
#pragma unroll
                        for (int kk = 0; kk < 4; ++kk) bnxt[kk] = *(const bf16x8*)(kq + 16 * kk); }
#pragma unroll
                    for (int g = 0; g < 4; ++g) {
                        f32x16 a;
#pragma unroll
                        for (int r = 0; r < 16; ++r) a[r] = 0.f;
#pragma unroll
                        for (int kk = 0; kk < 4; ++kk) a = __builtin_amdgcn_mfma_f32_32x32x16_bf16(af[g][kk], bcur[kk], a, 0, 0, 0);
                        float s0 = 0.f, s1 = 0.f;
#pragma unroll
                        for (int r = 0; r < 8; ++r) { s0 = fmaf(wv[g][r], fmaxf(a[r], 0.f), s0); s1 = fmaf(wv[g][8 + r], fmaxf(a[8 + r], 0.f), s1); }
                        SC[(4 * g + 2 * hi) * 2048 + 32 * jt + r32] = s0; SC[(4 * g + 2 * hi + 1) * 2048 + 32 * jt + r32] = s1;
                    }
#pragma unroll
                    for (int kk = 0; kk < 4; ++kk) bcur[kk] = bnxt[kk];
                }
            }
            __syncthreads();
            { const int q0 = 2 * wid, m0 = 16 * half + 2 * wid;
              if (V <= 256) { if (lane < 32) { MASK[m0 * 32 + lane] = (lane < ntile) ? ~0ull : 0ull; MASK[(m0 + 1) * 32 + lane] = (lane < ntile) ? ~0ull : 0ull; } }
              else if (ntile <= 8) select2<8>(SC, MASK, q0, m0, lane, ntile);
              else if (ntile <= 16) select2<16>(SC, MASK, q0, m0, lane, ntile);
              else if (ntile <= 24) select2<24>(SC, MASK, q0, m0, lane, ntile);
              else select2<32>(SC, MASK, q0, m0, lane, ntile); }
            __syncthreads();
        }
        tok0 = tokb + t0 + 4 * wid;
        Qw = (const bf16_t*)(w + WS_QB) + tok0 * 1024 + r32 * 128 + hi * 8;
        Kg = (const bf16_t*)(w + WS_KB) + tokb * 128; Vg = (const bf16_t*)(w + WS_VB) + tokb * 128;
        SG = (const bf16_t*)(w + WS_SGB);
    }
    float m_reg = -1e30f, l_reg = 0.f; f32x16 o[4];
#pragma unroll
    for (int d = 0; d < 4; ++d)
#pragma unroll
        for (int r = 0; r < 16; ++r) o[d][r] = 0.f;
    bf16x8 qr[8];
#pragma unroll
    for (int d0 = 0; d0 < 8; ++d0) qr[d0] = *(const bf16x8*)(Qw + d0 * 16);
    unsigned ko[2], vo[2]; dma_offsets(wid, lane, ldk, ko, vo);
    const size_t tstride = (size_t)64 * ldk * 2;
    asm volatile("s_waitcnt vmcnt(0) lgkmcnt(0)" ::: "memory"); __builtin_amdgcn_s_barrier(); asm volatile("" ::: "memory");
#pragma unroll
    for (int t = 0; t < 3; ++t) { const int tt = t < nsteps ? t : nsteps - 1; ADMA(t, (const char*)Kg + tt * tstride, (const char*)Vg + tt * tstride); }
    const int vb0 = (int)(uintptr_t)(lds + 16384) + v_rd_base(lane);
    const int ql = 4 * wid + (r32 >> 3);
    for (int s = 0; s < nsteps; ++s) {
        asm volatile("s_waitcnt vmcnt(8)" ::: "memory"); __builtin_amdgcn_s_barrier(); asm volatile("" ::: "memory");
        { const int tt = s + 3 < nsteps ? s + 3 : nsteps - 1; ADMA((s + 3) & 3, (const char*)Kg + tt * tstride, (const char*)Vg + tt * tstride); }
        const int slot = s & 3;
        bool active = true; int delta = 0;
        if (MODE == 0) { delta = cw - (kc0 + s); active = delta >= 0 && delta <= 8; }
        if (active) {
            f32x16 p0, p1; float mn, alpha; bf16x8 pa0, pa1, pa2, pa3;
            qkt(p0, p1, lds + slot * 32768, qr, r32, hi, (MODE == 0 && delta >= 3) ? cfar : 0.f);
            if (MODE == 0) {
                if (delta < 3) {
                    const LAS float* tb = tblx + (64 * delta + qo + 128 - 4 * hi - 63);
#pragma unroll
                    for (int r = 0; r < 16; ++r) { const int kk = (r & 3) + 8 * (r >> 2); p0[r] += tb[63 - kk]; p1[r] += tb[63 - kk - 32]; }
                }
            } else {
                const unsigned long long mw = MASK[ql * 32 + s]; const unsigned m0 = (unsigned)mw >> (4 * hi), m1 = (unsigned)(mw >> 32) >> (4 * hi);
#pragma unroll
                for (int r = 0; r < 16; ++r) { const unsigned bit = 1u << ((r & 3) + 8 * (r >> 2)); p0[r] = (m0 & bit) ? p0[r] : NEGB; p1[r] = (m1 & bit) ? p1[r] : NEGB; }
            }
            if (PROBE_DUP == 10) { f32x16 q0, q1; qkt(q0, q1, lds + slot * 32768, qr, r32, hi, 0.f); asm volatile("" :: "v"(q0), "v"(q1)); }
            if (PROBE_DUP == 11) { f32x16 q0 = p0, q1 = p1; float m2 = m_reg, l2 = l_reg, mn2, al2; bf16x8 qa0, qa1, qa2, qa3; asm volatile("" : "+v"(q0), "+v"(q1));
                partialSM(q0, q1, m2, mn2, al2); finishSM(q0, q1, al2, l2, qa0, qa1, qa2, qa3); asm volatile("" :: "v"(qa0), "v"(qa1), "v"(qa2), "v"(qa3), "v"(l2), "v"(m2)); }
            partialSM(p0, p1, m_reg, mn, alpha);
            RESC(alpha);
            finishSM(p0, p1, alpha, l_reg, pa0, pa1, pa2, pa3); SBAR();
            pv_d0(o, vb0 + slot * 32768, pa0, pa1, pa2, pa3);
            if (PROBE_DUP == 12) { f32x16 o2[2]; o2[0] = o[0]; o2[1] = o[1]; asm volatile("" : "+v"(o2[0]), "+v"(o2[1]));
                pv_one<0>(o2[0], vb0 + slot * 32768, pa0, pa1, pa2, pa3); pv_one<1>(o2[1], vb0 + slot * 32768, pa0, pa1, pa2, pa3); pv_one<2>(o2[0], vb0 + slot * 32768, pa0, pa1, pa2, pa3); pv_one<3>(o2[1], vb0 + slot * 32768, pa0, pa1, pa2, pa3);
                asm volatile("" :: "v"(o2[0]), "v"(o2[1])); }
        }
    }
    asm volatile("s_waitcnt vmcnt(0)" ::: "memory"); __builtin_amdgcn_s_barrier(); asm volatile("" ::: "memory");
    if (hi == 0) li_l[r32] = l_reg; asm volatile("s_waitcnt lgkmcnt(0)" ::: "memory");
    float gv[16][4];
#pragma unroll
    for (int r = 0; r < 16; ++r) { const int orow = crow(r, hi);
        const size_t goff = (MODE == 0) ? (tok0 + orow) * 1024 : (tok0 + (orow >> 3)) * 1024 + (orow & 7) * 128;
#pragma unroll
        for (int d0 = 0; d0 < 4; ++d0) gv[r][d0] = bf2f(SG[goff + d0 * 32 + r32]); }
#pragma unroll
    for (int r = 0; r < 16; ++r) { const int orow = crow(r, hi); const float rl = __builtin_amdgcn_rcpf(li_l[orow]);
        const size_t yoff = (MODE == 0) ? (tok0 + orow) * 2048 + ia * 128 : (tok0 + (orow >> 3)) * 2048 + 1024 + (orow & 7) * 128;
#pragma unroll
        for (int d0 = 0; d0 < 4; ++d0) YMIX[yoff + d0 * 32 + r32] = (bf16_t)(cvt_pk_bf16(o[d0][r] * rl * gv[r][d0], 0.f) & 0xffffu); }
    __syncthreads();
}

__device__ __forceinline__ unsigned f2bf(float f) { unsigned u = __float_as_uint(f); return (u + 0x7fffu + ((u >> 16) & 1u)) >> 16; }
__device__ __forceinline__ unsigned pk2(float lo, float hi) { return f2bf(lo) | (f2bf(hi) << 16); }
__device__ __forceinline__ int cat_src(int ns, int& col) {
    if (ns < 4096) { col = ns; return 0; }
    if (ns < 5120) { const int l = ns - 4096, head = l >> 7, s = l & 127, g = s >> 3, j = s & 7; col = C_QB + head * 128 + 4 * g + (j & 3) + 64 * (j >> 2); return 0; }
    if (ns < 6144) { col = C_GB + (ns - 5120); return 0; }
    if (ns < 6272) { const int s = ns - 6144, g = s >> 3, j = s & 7; col = C_KB + 4 * g + (j & 3) + 64 * (j >> 2); return 0; }
    if (ns < 6400) { col = C_VB + (ns - 6272); return 0; }
    if (ns < 6912) { const int l = ns - 6400, head = l >> 6, s = l & 63, g = s >> 3, j = s & 7; col = C_QI + head * 64 + 4 * g + (j & 3) + 32 * (j >> 2); return 0; }
    if (ns < 6976) { const int s = ns - 6912, g = s >> 3, j = s & 7; col = C_KI + 4 * g + (j & 3) + 32 * (j >> 2); return 0; }
    if (ns < 6984) { col = ns; return 0; }
    if (ns < 7168) { col = 0; return -1; }
    col = ns - 7168; return 1;
}
template <bool CAT> __device__ __forceinline__ void p0_cvt_task(const float* W, const float* W2, int K  , int N, bf16_t* WT, int nb, int k0, int klen, int lane) {
    const float* src = W; int col = nb * 64 + lane, ld = N; float msk = 1.f;
    if (CAT) { const int m = cat_src(nb * 64 + lane, col); if (m == 1) { src = W2; ld = D_MODEL; } else if (m < 0) { msk = 0.f; ld = DIN; } else ld = DIN; }
    const float* p = src + (size_t)k0 * ld + col;
    bf16_t* q = WT + (size_t)(nb * 64 + lane) * K + k0;
    for (int k = 0; k < klen; k += 64) {
        float v[64];
#pragma unroll
        for (int i = 0; i < 64; ++i) { v[i] = *p; p += ld; asm volatile("" : "+v"(p)); }
#pragma unroll
        for (int c = 0; c < 8; ++c) { u32x4 o; o.x = cvt_pk_bf16(v[8 * c + 0] * msk, v[8 * c + 1] * msk); o.y = cvt_pk_bf16(v[8 * c + 2] * msk, v[8 * c + 3] * msk);
            o.z = cvt_pk_bf16(v[8 * c + 4] * msk, v[8 * c + 5] * msk); o.w = cvt_pk_bf16(v[8 * c + 6] * msk, v[8 * c + 7] * msk);
            *(u32x4*)(q + k + 8 * c) = o; }
    }
}
__device__ __forceinline__ float wave_sum(float v) {
#pragma unroll
    for (int o = 1; o < 64; o <<= 1) v += __shfl_xor(v, o);
    return v;
}


#define XB_TMO      128
#define XB_XCNT(j)  (256  + 64 * (j))
#define XB_XSUB(j)  (1280 + 64 * (j))
#define XB_XGEN(j)  (2304 + 64 * (j))
#define XB_TOP      3328
#define XB_TOPGEN   3392
#define XCD_BAR_WORDS 3456
#define XB_SPIN_CAP (1u << 18)
__device__ __forceinline__ unsigned xb_ld(unsigned* p)              { return __hip_atomic_load(p, __ATOMIC_RELAXED, __HIP_MEMORY_SCOPE_AGENT); }
__device__ __forceinline__ unsigned xb_add(unsigned* p, unsigned v) { return __hip_atomic_fetch_add(p, v, __ATOMIC_RELAXED, __HIP_MEMORY_SCOPE_AGENT); }
__device__ __forceinline__ unsigned xb_xcc_id() { return (unsigned)__builtin_amdgcn_s_getreg((3 << 11) | 20) & 0xFu; }
#define XB_SPIN(cond, bar) do { unsigned _sp = 0; while (cond) { __builtin_amdgcn_s_sleep(1); \
    if ((++_sp & 255u) == 0u) { if (xb_ld(&(bar)[XB_TMO])) break; if (_sp > XB_SPIN_CAP) { atomicAdd(&(bar)[XB_TMO], 1u); break; } } } } while (0)
struct XcdBarrier { unsigned* bar; unsigned x; volatile LAS unsigned* st; };
__device__ __forceinline__ XcdBarrier xcd_barrier_post(unsigned* bar, volatile LAS unsigned* st) {
    XcdBarrier b; b.bar = bar; b.x = xb_xcc_id(); b.st = st;
    if (threadIdx.x == 0) (void)xb_add(&bar[XB_XCNT(b.x)], 1u);
    return b;
}
__device__ __forceinline__ void xcd_barrier_complete(unsigned* bar, unsigned x, unsigned& nloc, unsigned& nx) {
    const unsigned G = gridDim.x * gridDim.y * gridDim.z;
    unsigned sum, cnt, mine, sp = 0u;
    for (;;) {
        sum = 0u; cnt = 0u; mine = 0u;
#pragma unroll
        for (unsigned j = 0; j < 16; ++j) { const unsigned c = xb_ld(&bar[XB_XCNT(j)]); sum += c; cnt += (c > 0u) ? 1u : 0u; mine = (j == x) ? c : mine; }
        if (sum == G) break;
        __builtin_amdgcn_s_sleep(1);
        if ((++sp & 255u) == 0u) { if (xb_ld(&bar[XB_TMO])) break; if (sp > XB_SPIN_CAP) { atomicAdd(&bar[XB_TMO], 1u); break; } }
    }
    nloc = mine > 0u ? mine : 1u; nx = cnt > 0u ? cnt : 1u;
}
__device__ __forceinline__ void xcd_barrier(const XcdBarrier& b) {
    asm volatile("s_waitcnt vmcnt(0)" ::: "memory");
    __syncthreads();
    if (threadIdx.x == 0) {
        size_t bz_ = 0; asm volatile("" : "+s"(bz_)); unsigned* bar = b.bar + bz_;
        __builtin_amdgcn_s_waitcnt(0);
        unsigned nloc = b.st[0], nx = b.st[1];
        if (nloc == 0u) { xcd_barrier_complete(bar, b.x, nloc, nx); b.st[0] = nloc; b.st[1] = nx; }
        const unsigned old = xb_add(&bar[XB_XSUB(b.x)], 1u);
        const unsigned gen = old / nloc;
        if (old + 1u == (gen + 1u) * nloc) {
            __builtin_amdgcn_fence(__ATOMIC_RELEASE, "agent");
            asm volatile("s_waitcnt vmcnt(0)" ::: "memory");
            const unsigned og = xb_add(&bar[XB_TOP], 1u);
            const unsigned tg = og / nx;
            if (og + 1u == (tg + 1u) * nx) xb_add(&bar[XB_TOPGEN], 1u);
            else XB_SPIN(xb_ld(&bar[XB_TOPGEN]) == tg, bar);
            __builtin_amdgcn_fence(__ATOMIC_ACQUIRE, "agent");
            xb_add(&bar[XB_XGEN(b.x)], 1u);
            asm volatile("s_waitcnt vmcnt(0)" ::: "memory");
        } else {
            XB_SPIN(xb_ld(&bar[XB_XGEN(b.x)]) == gen, bar);
            __builtin_amdgcn_fence(__ATOMIC_ACQUIRE, "agent");
            asm volatile("s_waitcnt vmcnt(0)" ::: "memory");
        }
    }
    __syncthreads();
}

__global__ void __launch_bounds__(512, 2) mk_fwd(Args args) {
    extern __shared__ __attribute__((aligned(16))) unsigned char lds_raw[];
    LAS unsigned char* lds = (LAS unsigned char*)lds_raw;
    const int G = gridDim.x, bx = blockIdx.x;
#define TID_OPAQUE() int tid_ = threadIdx.x; asm volatile("" : "+v"(tid_)); const int tid = tid_, lane = tid & 63, wave = __builtin_amdgcn_readfirstlane(tid >> 6); (void)lane; (void)wave
    unsigned char* ws = args.ws;
#define WSB(name) size_t name##_z = 0; asm volatile("" : "+s"(name##_z)); unsigned char* name = ws + name##_z
    const int lo = args.ph_lo, hi_ph = args.ph_hi;
#define IN(k) (lo <= (k) && (k) < hi_ph)
#define GRID_SYNC(k) do { if (IN(k) && IN((k) + 1)) { xcd_barrier(xbar); } } while (0)
    { volatile LAS unsigned* lc = (volatile LAS unsigned*)(lds + L_CTL); if (threadIdx.x < 16) lc[threadIdx.x] = 0u; }
    __syncthreads();
    if (args.coop == 2) cg::this_grid().sync();
    XcdBarrier xbar = xcd_barrier_post((unsigned*)(ws + WS_CTL) + CW_BAR, (volatile LAS unsigned*)(lds + L_CTL + 16));

    for (int rep = 0; rep < (PROBE_DUP == 1 ? 2 : 1); ++rep)
    if (IN(0)) {
        TID_OPAQUE(); WSB(w);
        const float* x_in = args.in[0]; const float* p_in = args.in[1]; const int* pos = (const int*)args.in[2];
        const float* w_in = args.in[3]; const float* w_out = args.in[6]; const float* w_ple = args.in[7]; const float* w_pg = args.in[8];
        bf16_t* WCAT = (bf16_t*)(w + WS_WCAT); bf16_t* WOUT = (bf16_t*)(w + WS_WOUT); bf16_t* WPLE = (bf16_t*)(w + WS_WPLE); bf16_t* PBF = (bf16_t*)(w + WS_PBF); bf16_t* XB = (bf16_t*)(w + WS_XB);
        float* COSH = (float*)(w + WS_COSH); float* SINH = (float*)(w + WS_SINH); float* COSI = (float*)(w + WS_COSI); float* SINI = (float*)(w + WS_SINI);
        const int gw = bx * 8 + wave, NGW = G * 8;
        constexpr int KT = 256;
        constexpr int I_CAT = (NCAT / 64) * (D_MODEL / KT), I_OUT = (D_MODEL / 64) * (D_MODEL / KT), I_PLE = (D_MODEL / 64) * (DPLE / KT), I_L = I_CAT + I_OUT + I_PLE;
#pragma nounroll
        for (int rep2 = 0; rep2 < (PROBE_DUP == 8 ? 2 : 1); ++rep2)
        for (int it = gw; it < DEPTH * I_L; it += NGW) {
            const int l = it / I_L; int r = it % I_L;
            if (r < I_CAT) { p0_cvt_task<true>(w_in + (size_t)l * D_MODEL * DIN, w_pg + (size_t)l * D_MODEL * D_MODEL, WPITCH, NCAT, WCAT + (size_t)l * NCAT * WPITCH, r % (NCAT / 64), (r / (NCAT / 64)) * KT, KT, lane); continue; }
            r -= I_CAT;
            if (r < I_OUT) { p0_cvt_task<false>(w_out + (size_t)l * D_MODEL * D_MODEL, nullptr, WPITCH, D_MODEL, WOUT + (size_t)l * D_MODEL * WPITCH, r % (D_MODEL / 64), (r / (D_MODEL / 64)) * KT, KT, lane); continue; }
            r -= I_OUT;
            p0_cvt_task<false>(w_ple + (size_t)l * DPLE * D_MODEL, nullptr, PPITCH, D_MODEL, WPLE + (size_t)l * D_MODEL * PPITCH, r % (D_MODEL / 64), (r / (D_MODEL / 64)) * KT, KT, lane);
        }
        const size_t gt = (size_t)bx * 512 + tid, NT_ = (size_t)G * 512;
#pragma nounroll
        for (int rep3 = 0; rep3 < (PROBE_DUP == 9 ? 2 : 1); ++rep3) {
        for (size_t i = gt; i < (size_t)T * D_MODEL / 8; i += 4 * NT_) {
            f32x4 a[4], c[4];
#pragma unroll
            for (int u = 0; u < 4; ++u) if (i + u * NT_ < (size_t)T * D_MODEL / 8) { a[u] = ld4(x_in + (i + u * NT_) * 8); c[u] = ld4(x_in + (i + u * NT_) * 8 + 4); }
#pragma unroll
            for (int u = 0; u < 4; ++u) if (i + u * NT_ < (size_t)T * D_MODEL / 8) st_bf8(XB + (i + u * NT_) * 8, a[u], c[u]);
        }
        for (size_t i = gt; i < (size_t)DEPTH * T * DPLE / 8; i += 4 * NT_) {
            f32x4 a[4], c[4];
#pragma unroll
            for (int u = 0; u < 4; ++u) if (i + u * NT_ < (size_t)DEPTH * T * DPLE / 8) { a[u] = ld4(p_in + (i + u * NT_) * 8); c[u] = ld4(p_in + (i + u * NT_) * 8 + 4); }
#pragma unroll
            for (int u = 0; u < 4; ++u) if (i + u * NT_ < (size_t)DEPTH * T * DPLE / 8) st_bf8(PBF + (i + u * NT_) * 8, a[u], c[u]);
        }
        for (unsigned i = (unsigned)gt; i < (unsigned)T * 96u; i += (unsigned)NT_) {
            const unsigned tok = i / 96u, j = i - tok * 96u; const float pf = (float)pos[tok];
            const float ang = pf * (j < 64u ? args.inv.h[j] : args.inv.i[j - 64u]);
            double tt = (double)ang * 0.15915494309189533577; tt -= rint(tt);
            const float r = (float)(tt * 6.28318530717958647692);
            float sv, cv; sincosf(r, &sv, &cv);
            if (j < 64u) { COSH[tok * 64u + j] = cv; SINH[tok * 64u + j] = sv; } else { COSI[tok * 32u + (j - 64u)] = cv; SINI[tok * 32u + (j - 64u)] = sv; }
        }
        }
    }
    GRID_SYNC(0);

    for (int l = 0; l < DEPTH; ++l) {
        const int pb = 1 + 4 * l;
        for (int rep = 0; rep < (PROBE_DUP == 2 ? 2 : 1); ++rep)
        if (IN(pb)) {
            { WSB(w); pg8::Gemm g{(const bf16_t*)(w + WS_XB), (const bf16_t*)(w + WS_WCAT) + (size_t)l * NCAT * WPITCH, T, 8192, D_MODEL, WPITCH}; pg8::StaticOrder S; S.init(T, 8192, G, bx);
              EpiProj E{ws, args.in[4] + (size_t)l * DIN, args.in[9] + (size_t)l * D_MODEL};
              pg8::gemm_phase<EpiProj, pg8::StaticOrder, true, true>(lds, g, S, E); }
        }
        GRID_SYNC(pb);
        for (int rep = 0; rep < (PROBE_DUP == 3 ? 2 : 1); ++rep)
        if (IN(pb + 1)) {
            TID_OPAQUE(); LAS int* bc = (LAS int*)(lds + L_CTL);
            WSB(w); unsigned* head = (unsigned*)(w + WS_CTL) + CW_QUEUE + 64 * (l + 4 * rep);
            for (;;) {
                __syncthreads();
                if (tid == 0) bc[0] = (int)__hip_atomic_fetch_add(head, 1u, __ATOMIC_RELAXED, __HIP_MEMORY_SCOPE_AGENT);
                __syncthreads();
                const int it = bc[0];
                if (it >= 896) break;
                if (it < 128) {
                    pg8::Gemm g{(const bf16_t*)(w + WS_XB), (const bf16_t*)(w + WS_WCAT) + (size_t)l * NCAT * WPITCH, T, NCAT, D_MODEL, WPITCH}; pg8::OneUnit S; S.u.pm = it & 31; S.u.pn = 32 + (it >> 5);
                    EpiProj E{ws, args.in[4] + (size_t)l * DIN, args.in[9] + (size_t)l * D_MODEL};
                    pg8::gemm_phase<EpiProj, pg8::OneUnit, false, true>(lds, g, S, E);
                    continue;
                }
                if (it >= 640) {
                    const int k = it - 640;
                    pg8::Gemm g{(const bf16_t*)(w + WS_PBF) + (size_t)l * T * DPLE, (const bf16_t*)(w + WS_WPLE) + (size_t)l * D_MODEL * PPITCH, T, D_MODEL, DPLE, PPITCH}; pg8::OneUnit S; S.u.pm = k & 31; S.u.pn = k >> 5;
                    EpiPlain E{(bf16_t*)(w + WS_PLE), D_MODEL};
                    pg8::gemm_phase<EpiPlain, pg8::OneUnit, false, true>(lds, g, S, E);
                    continue;
                }
                const int it2 = it - 128;
                int isB, cidx, sub;
                if (it2 < 192) { isB = 1; cidx = 31 - (it2 >> 3); sub = it2 & 7; }
                else if (it2 < 384) { isB = 0; const int k = it2 - 192; cidx = 2 + k / 32; sub = k % 32; }
                else if (it2 < 416) { isB = 1; const int k = it2 - 384; cidx = 7 - (k >> 3); sub = k & 7; }
                else if (it2 < 448) { isB = 0; cidx = 1; sub = it2 - 416; }
                else if (it2 < 480) { isB = 1; const int k = it2 - 448; cidx = 3 - (k >> 3); sub = k & 7; }
                else { isB = 0; cidx = 0; sub = it2 - 480; }
                if (isB) { attn_unit<1>(lds, sub >> 1, cidx * 2 + (sub & 1), 0, w, nullptr); if (PROBE_DUP == 5) attn_unit<1>(lds, sub >> 1, cidx * 2 + (sub & 1), 0, w, nullptr); }
                else { attn_unit<0>(lds, sub >> 3, sub & 7, cidx, w, args.in[5] + (size_t)l * 8 * 257); if (PROBE_DUP == 4) attn_unit<0>(lds, sub >> 3, sub & 7, cidx, w, args.in[5] + (size_t)l * 8 * 257); }
            }
        }
        GRID_SYNC(pb + 1);
        if (IN(pb + 2)) {
            WSB(w); pg8::Gemm g{(const bf16_t*)(w + WS_YMIX), (const bf16_t*)(w + WS_WOUT) + (size_t)l * D_MODEL * WPITCH, T, D_MODEL, D_MODEL, WPITCH}; pg8::StaticOrder S; S.init(T, D_MODEL, G, bx);
            EpiRes E{(l == 0) ? args.in[0] : (const float*)(w + WS_XF), ws};
            pg8::gemm_phase<EpiRes, pg8::StaticOrder, true, true>(lds, g, S, E);
        }
        GRID_SYNC(pb + 2);
        if (IN(pb + 3)) {
            TID_OPAQUE(); WSB(w); float* XF = (float*)(w + WS_XF); bf16_t* XB = (bf16_t*)(w + WS_XB);
            const int gw = bx * 8 + wave, NGW = G * 8;
            const float* gg = args.in[10] + (size_t)l * D_MODEL; const float* bb = args.in[11] + (size_t)l * D_MODEL;
            float* dstf = (l == DEPTH - 1) ? args.out : XF;
            for (int m = gw; m < T; m += NGW) {
                const float* xr = XF + (size_t)m * D_MODEL + 4 * lane;
                f32x4 v[8]; float s = 0.f;
#pragma unroll
                for (int j = 0; j < 8; ++j) { v[j] = ld4(xr + 256 * j); s += (v[j][0] + v[j][1]) + (v[j][2] + v[j][3]); }
                const float mean = wave_sum(s) * (1.f / D_MODEL); float s2 = 0.f;
#pragma unroll
                for (int j = 0; j < 8; ++j) { v[j] = v[j] - mean; s2 += (v[j][0] * v[j][0] + v[j][1] * v[j][1]) + (v[j][2] * v[j][2] + v[j][3] * v[j][3]); }
                const float rstd = 1.f / sqrtf(wave_sum(s2) * (1.f / D_MODEL) + LN_EPS);
#pragma unroll
                for (int j = 0; j < 8; ++j) { const f32x4 gv = ld4(gg + 4 * lane + 256 * j), bv = ld4(bb + 4 * lane + 256 * j); const f32x4 y = v[j] * rstd * gv + bv;
                    *(f32x4*)(dstf + (size_t)m * D_MODEL + 4 * lane + 256 * j) = y;
                    if (l != DEPTH - 1) st_bf4(XB + (size_t)m * D_MODEL + 4 * lane + 256 * j, y); }
            }
        }
        if (l != DEPTH - 1) GRID_SYNC(pb + 3);
    }
#undef IN
#undef GRID_SYNC
}

extern "C" void kernel_launch(void* const* d_in, const int* in_sizes, int n_in, void* d_out, int out_size, void* d_ws, size_t ws_size, hipStream_t stream) {
    static int grid = 0;
    if (grid == 0) {
        if (n_in != 12 || out_size != T * D_MODEL || ws_size < WS_END) { fprintf(stderr, "kernel_launch: unexpected shapes n_in %d out %d ws %zu (need %zu)\n", n_in, out_size, ws_size, (size_t)WS_END); grid = -1; return; }
        int dev = 0, cus = 0, per_cu = 0;
        hipGetDevice(&dev); hipDeviceGetAttribute(&cus, hipDeviceAttributeMultiprocessorCount, dev);
        if (hipFuncSetAttribute((const void*)mk_fwd, hipFuncAttributeMaxDynamicSharedMemorySize, LDS_BYTES) != hipSuccess) { fprintf(stderr, "kernel_launch: hipFuncSetAttribute failed\n"); grid = -1; return; }
        if (hipOccupancyMaxActiveBlocksPerMultiprocessor(&per_cu, (const void*)mk_fwd, 512, LDS_BYTES) != hipSuccess || per_cu < 1) { fprintf(stderr, "kernel_launch: occupancy query says %d\n", per_cu); per_cu = 1; }
        (void)hipGetLastError();
        grid = cus;
        fprintf(stderr, "kernel_launch: cus %d per_cu %d grid %d\n", cus, per_cu, grid);
    }
    if (grid < 0) return;
    hipMemsetAsync((char*)d_ws + WS_CTL, 0, CTL_BYTES, stream);
    Args a{};
    for (int i = 0; i < 12; ++i) a.in[i] = (const float*)d_in[i];
    a.out = (float*)d_out; a.ws = (unsigned char*)d_ws;
    for (int i = 0; i < 64; ++i) a.inv.h[i] = (float)std::pow(10000.0, -(double)(2 * i) / 128.0);
    for (int i = 0; i < 32; ++i) a.inv.i[i] = (float)std::pow(10000.0, -(double)(2 * i) / 64.0);
    constexpr int NPH = 1 + 4 * DEPTH;
#if MK_N_LAUNCHES == 1
    a.ph_lo = 0; a.ph_hi = NPH; a.coop = 1;
    void* kargs[] = {&a};
    hipError_t e = hipLaunchCooperativeKernel((const void*)mk_fwd, dim3(grid), dim3(512), kargs, LDS_BYTES, stream);
    if (e != hipSuccess) fprintf(stderr, "kernel_launch: cooperative launch failed: %s (grid %d)\n", hipGetErrorString(e), grid);
#else
    for (int ph = 0; ph < NPH; ++ph) { a.ph_lo = ph; a.ph_hi = ph + 1; a.coop = 0; hipLaunchKernelGGL(mk_fwd, dim3(grid), dim3(512), LDS_BYTES, stream, a); }
#endif
}
```
